# Optimizing an MI355X kernel written in HIP

```python
import math
import jax, jax.numpy as jnp
from jax import lax
import numpy as np

D_MODEL = 2048
BATCH = 1
SEQ = 8192
DEPTH = 1
DEC_BATCH = 8
DEC_SEQ = 64
PAST_LEN = 4096

CHUNK = 64
QBLOCK = 128
MIX_WIDTH = D_MODEL
HG_WIDTH = MIX_WIDTH // 2
ATT_WIDTH = MIX_WIDTH - HG_WIDTH
HG_EXPAND = 128
HG_HEADS = HG_WIDTH // HG_EXPAND
HG_DK = HG_EXPAND
HG_DV = HG_WIDTH // HG_HEADS
ATT_HEADS = 8
ATT_DV = ATT_WIDTH // ATT_HEADS
ATT_DH = ATT_DV // 2
D_FF = 4 * D_MODEL
IN_WIDTH = 4 * HG_WIDTH + 3 * ATT_WIDTH
EPS = 1e-6
NEG_INF = -1e30

kernel_name = "hymba_hgrn2_diffattn_streaming_step"


def rmsnorm(x, gain, out_dtype):
    xf = x.astype(jnp.float32)
    y = xf * lax.rsqrt(jnp.mean(xf * xf, axis=-1, keepdims=True) + EPS)
    return (y * gain.astype(jnp.float32)).astype(out_dtype)


def lambda_init_fn(layer_idx):
    return 0.8 - 0.6 * math.exp(-0.3 * layer_idx)


def gla_chunkwise(q, k, v, logf, s0):
    B, L, H, DK = q.shape
    DV = v.shape[-1]
    n = -(-L // CHUNK)
    pad = n * CHUNK - L

    def prep(a):
        a = jnp.pad(a.astype(jnp.float32), ((0, 0), (0, pad), (0, 0), (0, 0)))
        return a.reshape(B, n, CHUNK, H, a.shape[-1]).transpose(1, 0, 2, 3, 4)

    qs, ks, vs, gs = prep(q), prep(k), prep(v), prep(logf)
    causal = jnp.tril(jnp.ones((CHUNK, CHUNK), dtype=bool))[None, :, :, None, None]

    def step(S, xs):
        qc, kc, vc, gc = xs
        b = jnp.cumsum(gc, axis=1)
        o_inter = jnp.einsum('bthk,bhkv->bthv', qc * jnp.exp(b), S)
        diff = b[:, :, None] - b[:, None, :]
        decay = jnp.where(causal, jnp.exp(jnp.minimum(diff, 0.0)), 0.0)
        A = jnp.einsum('bthk,bshk,btshk->bhts', qc, kc, decay)
        o_intra = jnp.einsum('bhts,bshv->bthv', A, vc)
        b_last = b[:, -1]
        k_dec = kc * jnp.exp(b_last[:, None] - b)
        S_new = jnp.exp(b_last)[..., None] * S + jnp.einsum('bshk,bshv->bhkv', k_dec, vc)
        return S_new, o_inter + o_intra

    S_fin, o = lax.scan(step, s0.astype(jnp.float32), (qs, ks, vs, gs))
    o = o.transpose(1, 0, 2, 3, 4).reshape(B, n * CHUNK, H, DV)[:, :L]
    return o, S_fin


def diff_attn_block(q, k, v, q_pos, k_pos, lam):
    s = jnp.einsum('bqhcd,bkhcd->bhcqk', q.astype(jnp.float32), k.astype(jnp.float32)) * (ATT_DH ** -0.5)
    mask = (k_pos // CHUNK)[None, :] <= (q_pos // CHUNK)[:, None]
    s = jnp.where(mask, s, NEG_INF)
    p = jax.nn.softmax(s, axis=-1)
    w = p[:, :, 0] - lam * p[:, :, 1]
    return jnp.einsum('bhqk,bkhv->bqhv', w, v.astype(jnp.float32))


def trunk_layer(x, l, s0, past_k, past_v, norm_attn, w_in, lower_bounds, hg_norm,
                lambda_q1, lambda_k1, lambda_q2, lambda_k2, subln, w_out, norm_mlp, w_up, w_down):
    B, L, _ = x.shape
    dt = x.dtype
    h = rmsnorm(x, norm_attn[l], dt)
    p = h @ w_in[l]
    o0 = 0
    hq = p[..., o0:o0 + HG_WIDTH]; o0 += HG_WIDTH
    hf = p[..., o0:o0 + HG_WIDTH]; o0 += HG_WIDTH
    hi = p[..., o0:o0 + HG_WIDTH]; o0 += HG_WIDTH
    hg = p[..., o0:o0 + HG_WIDTH]; o0 += HG_WIDTH
    aq = p[..., o0:o0 + ATT_WIDTH]; o0 += ATT_WIDTH
    ak = p[..., o0:o0 + ATT_WIDTH]; o0 += ATT_WIDTH
    av = p[..., o0:o0 + ATT_WIDTH]

    lb = jnp.cumsum(jax.nn.softmax(lower_bounds.astype(jnp.float32), axis=0), axis=0)[l]
    f = lb + (1.0 - lb) * jax.nn.sigmoid(hf.astype(jnp.float32))
    logf = jnp.log(f)
    kg = 1.0 - f
    qg = jax.nn.silu(hq)
    heads_k = lambda a: a.reshape(B, L, HG_HEADS, HG_DK)
    o_hg, s_new = gla_chunkwise(heads_k(qg), heads_k(kg), hi.reshape(B, L, HG_HEADS, HG_DV),
                                heads_k(logf), s0)
    o_hg = rmsnorm(o_hg, hg_norm[l], jnp.float32) * jax.nn.silu(
        hg.reshape(B, L, HG_HEADS, HG_DV).astype(jnp.float32))

    lam_init = lambda_init_fn(l)
    lam = (jnp.exp(jnp.sum(lambda_q1[l].astype(jnp.float32) * lambda_k1[l].astype(jnp.float32)))
           - jnp.exp(jnp.sum(lambda_q2[l].astype(jnp.float32) * lambda_k2[l].astype(jnp.float32)))
           + lam_init)
    q5 = aq.reshape(B, L, ATT_HEADS, 2, ATT_DH)
    k5 = ak.reshape(B, L, ATT_HEADS, 2, ATT_DH)
    v4 = av.reshape(B, L, ATT_HEADS, ATT_DV)
    if past_k is None:
        k_pos = jnp.arange(L)

        def blk(i):
            qb = lax.dynamic_slice_in_dim(q5, i * QBLOCK, QBLOCK, axis=1)
            q_pos = i * QBLOCK + jnp.arange(QBLOCK)
            return diff_attn_block(qb, k5, v4, q_pos, k_pos, lam)

        o_at = lax.map(blk, jnp.arange(L // QBLOCK))
        o_at = o_at.transpose(1, 0, 2, 3, 4).reshape(B, L, ATT_HEADS, ATT_DV)
    else:
        P = past_k.shape[1]
        k_all = jnp.concatenate([past_k.reshape(B, P, ATT_HEADS, 2, ATT_DH).astype(k5.dtype), k5], axis=1)
        v_all = jnp.concatenate([past_v.astype(v4.dtype), v4], axis=1)
        q_pos = P + jnp.arange(L)
        k_pos = jnp.arange(P + L)
        o_at = diff_attn_block(q5, k_all, v_all, q_pos, k_pos, lam)
    o_at = rmsnorm(o_at, subln[l], jnp.float32) * (1.0 - lam_init)

    mix = jnp.concatenate([o_hg.reshape(B, L, HG_WIDTH), o_at.reshape(B, L, ATT_WIDTH)], axis=-1).astype(dt)
    x = x + mix @ w_out[l]
    hm = rmsnorm(x, norm_mlp[l], dt)
    x = x + jnp.square(jax.nn.relu(hm @ w_up[l])) @ w_down[l]
    return x, ak.reshape(B, L, ATT_HEADS, 2 * ATT_DH), v4, s_new


def setup_inputs(seed: int = 0) -> dict:
    key = jax.random.key(seed)
    ks = jax.random.split(key, 24)
    nrm = lambda k, shape, scale: jax.random.normal(k, shape, jnp.float32) * scale
    return {
        "x_prompt": nrm(ks[0], (BATCH, SEQ, D_MODEL), 1.0),
        "x_sample": nrm(ks[1], (DEC_BATCH, DEC_SEQ, D_MODEL), 1.0),
        "cache_k": nrm(ks[2], (DEPTH, DEC_BATCH, PAST_LEN, ATT_HEADS, 2 * ATT_DH), 1.0),
        "cache_v": nrm(ks[3], (DEPTH, DEC_BATCH, PAST_LEN, ATT_HEADS, ATT_DV), 1.0),
        "state_hgrn": nrm(ks[4], (DEPTH, DEC_BATCH, HG_HEADS, HG_DK, HG_DV), 0.1),
        "norm_attn": 1.0 + nrm(ks[5], (DEPTH, D_MODEL), 0.02),
        "w_in": nrm(ks[6], (DEPTH, D_MODEL, IN_WIDTH), D_MODEL ** -0.5),
        "lower_bounds": nrm(ks[7], (DEPTH + 1, HG_WIDTH), 0.1),
        "hg_norm": 1.0 + nrm(ks[8], (DEPTH, HG_DV), 0.02),
        "lambda_q1": nrm(ks[9], (DEPTH, ATT_DH), 0.1),
        "lambda_k1": nrm(ks[10], (DEPTH, ATT_DH), 0.1),
        "lambda_q2": nrm(ks[11], (DEPTH, ATT_DH), 0.1),
        "lambda_k2": nrm(ks[12], (DEPTH, ATT_DH), 0.1),
        "subln": 1.0 + nrm(ks[13], (DEPTH, ATT_DV), 0.02),
        "w_out": nrm(ks[14], (DEPTH, MIX_WIDTH, D_MODEL), MIX_WIDTH ** -0.5),
        "norm_mlp": 1.0 + nrm(ks[15], (DEPTH, D_MODEL), 0.02),
        "w_up": nrm(ks[16], (DEPTH, D_MODEL, D_FF), D_MODEL ** -0.5),
        "w_down": nrm(ks[17], (DEPTH, D_FF, D_MODEL), D_FF ** -0.5),
        "norm_final": 1.0 + nrm(ks[18], (D_MODEL,), 0.02),
    }


def reference(x_prompt, x_sample, cache_k, cache_v, state_hgrn, norm_attn, w_in, lower_bounds,
              hg_norm, lambda_q1, lambda_k1, lambda_q2, lambda_k2, subln, w_out, norm_mlp,
              w_up, w_down, norm_final):
    xp, xs = x_prompt, x_sample
    kp_list, vp_list, sp_list, ksl, vsl, ssl = [], [], [], [], [], []
    s0_prompt = jnp.zeros((xp.shape[0], HG_HEADS, HG_DK, HG_DV), jnp.float32)
    for l in range(DEPTH):
        xp, kp, vp, sp = trunk_layer(xp, l, s0_prompt, None, None, norm_attn, w_in, lower_bounds,
                                     hg_norm, lambda_q1, lambda_k1, lambda_q2, lambda_k2, subln,
                                     w_out, norm_mlp, w_up, w_down)
        xs, k_s, v_s, s_s = trunk_layer(xs, l, state_hgrn[l], cache_k[l], cache_v[l], norm_attn, w_in,
                                        lower_bounds, hg_norm, lambda_q1, lambda_k1, lambda_q2,
                                        lambda_k2, subln, w_out, norm_mlp, w_up, w_down)
        kp_list.append(kp); vp_list.append(vp); sp_list.append(sp)
        ksl.append(k_s); vsl.append(v_s); ssl.append(s_s)
    y_prompt = rmsnorm(xp, norm_final, xp.dtype)
    y_sample = rmsnorm(xs, norm_final, xs.dtype)
    new_k_prompt = jnp.stack(kp_list, axis=0)
    new_v_prompt = jnp.stack(vp_list, axis=0)
    new_state_prompt = jnp.stack(sp_list, axis=0)
    new_k_sample = jnp.stack(ksl, axis=0)
    new_v_sample = jnp.stack(vsl, axis=0)
    new_state_sample = jnp.stack(ssl, axis=0)
    return (y_prompt, y_sample, new_k_prompt, new_v_prompt, new_state_prompt,
            new_k_sample, new_v_sample, new_state_sample)
```

```cpp
#include <hip/hip_runtime.h>
#include <hip/hip_cooperative_groups.h>
#include <cstdio>
#include <cstdint>
namespace cg = cooperative_groups;
namespace pg8 {
#define PG8_LAS __attribute__((address_space(3)))
typedef unsigned short bf16_t;
typedef short bf16x8 __attribute__((ext_vector_type(8)));
typedef float f32x4 __attribute__((ext_vector_type(4)));
typedef unsigned u32x4 __attribute__((ext_vector_type(4)));
constexpr int BM = 256, BK = 64, HALF = 128, HTB = HALF * BK * 2  , STAGE_BYTES = 8 * HTB, NXCD = 8, WGM = 8;

__host__ __device__ __forceinline__ int lds_byte(int r, int c) { const int st = (r >> 4) * 2 + (c >> 5), rr = r & 15, cc = c & 31, ob = rr * 64 + cc * 2; return st * 1024 + (ob ^ (((ob >> 9) & 1) << 5)); }
__host__ __device__ __forceinline__ void stage_rc(int b, int& R, int& C) { const int st = b / 1024, sb = b % 1024, swz = sb ^ (((sb >> 9) & 1) << 5); R = (st >> 1) * 16 + swz / 64; C = (st & 1) * 32 + (swz % 64) / 2; }
__host__ __device__ __forceinline__ int perm32(int rho) { const int n = rho >> 4, i = rho & 15; return 8 * (i >> 2) + 4 * n + (i & 3); }

struct Unit { int pm, pn, k0, nt, kind; };
struct Gemm { const bf16_t* A; const bf16_t* Bt; int M, N, K; };

struct StaticOrder {
    int nM, nN, nwg, G, c, ntk;
    __host__ __device__ void init(int M, int N, int G_, int c_, int ntk_) { nM = M / BM; nN = N / BM; nwg = nM * nN; G = G_; c = c_; ntk = ntk_; }
    __host__ __device__ bool next(int i, Unit& u) const {
        const long L = (long)i * G + c; if (L >= nwg) return false;
        int wgid = (int)L; { const int q = nwg / NXCD, r = nwg % NXCD, xcd = wgid % NXCD, off = wgid / NXCD; wgid = (xcd < r ? xcd * (q + 1) : r * (q + 1) + (xcd - r) * q) + off; }
        const int nig = WGM * nN, gid = wgid / nig, fm = gid * WGM, gsz = (nM - fm) < WGM ? (nM - fm) : WGM;
        u.pm = fm + ((wgid % nig) % gsz); u.pn = (wgid % nig) / gsz; u.k0 = 0; u.nt = ntk; u.kind = 0; return true;
    }
    __device__ __forceinline__ void a_ready(const Unit&) const {}
    __device__ __forceinline__ void done(const Unit&) const {}
};

__device__ __forceinline__ unsigned cvt_pk_bf16(float lo, float hi) { unsigned r; asm volatile("v_cvt_pk_bf16_f32 %0, %1, %2" : "=v"(r) : "v"(lo), "v"(hi)); return r; }
typedef float f32x2 __attribute__((ext_vector_type(2)));
template <class Epi, class Sched, bool ALIGN_EPI = false, bool SP2 = false>
__device__ __forceinline__ void gemm_phase(PG8_LAS unsigned char* lds, const Gemm g, const Sched& S, const Epi& E) {
    const int tid = threadIdx.x, wid = __builtin_amdgcn_readfirstlane(tid >> 6), lane = tid & 63, wr = wid >> 2, wc = wid & 3, fr = lane & 15, fq = lane >> 4;
    const int K = g.K;
    unsigned voffA[2], voffB[2];
#pragma unroll
    for (int i = 0; i < 2; ++i) { int R, C; stage_rc(tid * 16 + i * 8192, R, C); const int Rb = Epi::PERM ? ((R & ~31) + perm32(R & 31)) : R;
        voffA[i] = (unsigned)(R * K + C) * 2u; voffB[i] = (unsigned)(Rb * K + C) * 2u; }
    const size_t kstep = (size_t)(BK * 2);
    const size_t hstep = (size_t)HALF * K * 2;
    const size_t tstep = 2 * hstep;
    const unsigned ldsw = (unsigned)wid * 1024u;
    const int aoff = lds_byte(wr * 64 + fr, fq * 8), boff = lds_byte(wc * 32 + fr, fq * 8);
#define PG8_SA(b, h) (((b) * 2 + (h)) * HTB)
#define PG8_SB(b, h) ((4 + (b) * 2 + (h)) * HTB)
#define PG8_STAGE(bufoff, gbase, voff) do { _Pragma("unroll") for (int _i = 0; _i < 2; ++_i) \
        __builtin_amdgcn_global_load_lds((const unsigned*)((const char*)(gbase) + (voff)[_i]), (PG8_LAS unsigned*)(lds + (bufoff) + ldsw + _i * 8192), 16, 0, 0); } while (0)
#define PG8_LDA(dst, b, h) do { _Pragma("unroll") for (int m = 0; m < 4; ++m) _Pragma("unroll") for (int k = 0; k < 2; ++k) dst[m][k] = *(const PG8_LAS bf16x8*)(lds + PG8_SA(b, h) + aoff + m * 2048 + k * 1024); } while (0)
#define PG8_LDB(dst, b, h) do { _Pragma("unroll") for (int n = 0; n < 2; ++n) _Pragma("unroll") for (int k = 0; k < 2; ++k) dst[n][k] = *(const PG8_LAS bf16x8*)(lds + PG8_SB(b, h) + boff + n * 2048 + k * 1024); } while (0)
#define PG8_MMA(ai, bj, At, Bt) do { __builtin_amdgcn_s_setprio(1); _Pragma("unroll") for (int m = 0; m < 4; ++m) _Pragma("unroll") for (int n = 0; n < 2; ++n) _Pragma("unroll") for (int k = 0; k < 2; ++k) \
        acc[ai][bj][m][n] = __builtin_amdgcn_mfma_f32_16x16x32_bf16(Bt[n][k], At[m][k], acc[ai][bj][m][n], 0, 0, 0); __builtin_amdgcn_s_setprio(0); } while (0)
#define PG8_WAIT_V(n) asm volatile("s_waitcnt vmcnt(" #n ")" ::: "memory")
#define PG8_WAIT_L(n) asm volatile("s_waitcnt lgkmcnt(" #n ")" ::: "memory")
#define PG8_BAR __builtin_amdgcn_s_barrier()
#define PG8_SCHED __builtin_amdgcn_sched_barrier(0)
    Unit cur, nxt; int ui = 0;
    if (!S.next(0, cur)) return;
    f32x4 acc[2][2][4][2];
#pragma unroll
    for (int a = 0; a < 2; ++a)
#pragma unroll
        for (int b = 0; b < 2; ++b)
#pragma unroll
            for (int m = 0; m < 4; ++m)
#pragma unroll
                for (int n = 0; n < 2; ++n) acc[a][b][m][n] = (f32x4){0.f, 0.f, 0.f, 0.f};
    bf16x8 At[4][2], B0[2][2], B1[2][2];
    const char* cA = (const char*)g.A + (size_t)cur.pm * tstep + (size_t)cur.k0 * kstep; const char* cB = (const char*)g.Bt + (size_t)cur.pn * tstep + (size_t)cur.k0 * kstep;
    S.a_ready(cur);
    if constexpr (SP2) {
        PG8_STAGE(PG8_SB(0, 0), cB, voffB); PG8_STAGE(PG8_SB(0, 1), cB + hstep, voffB); PG8_STAGE(PG8_SA(0, 0), cA, voffA); PG8_STAGE(PG8_SA(0, 1), cA + hstep, voffA);
        if (wr == 1) PG8_BAR;
        PG8_WAIT_V(2); PG8_BAR;
        PG8_STAGE(PG8_SB(1, 0), cB + kstep, voffB); PG8_STAGE(PG8_SA(1, 0), cA + kstep, voffA); PG8_STAGE(PG8_SB(1, 1), cB + hstep + kstep, voffB);
        PG8_WAIT_V(6); PG8_BAR;
    } else {
        PG8_STAGE(PG8_SB(0, 0), cB, voffB); PG8_STAGE(PG8_SA(0, 0), cA, voffA); PG8_STAGE(PG8_SB(0, 1), cB + hstep, voffB); PG8_STAGE(PG8_SA(0, 1), cA + hstep, voffA);
        if (wr == 1) PG8_BAR;
        PG8_WAIT_V(4); PG8_BAR;
        PG8_STAGE(PG8_SB(1, 0), cB + kstep, voffB); PG8_STAGE(PG8_SA(1, 0), cA + kstep, voffA); PG8_STAGE(PG8_SB(1, 1), cB + hstep + kstep, voffB);
        PG8_WAIT_V(6); PG8_BAR;
    }
    for (;;) {
        const bool has_next = S.next(ui + 1, nxt);
        const char* nA = has_next ? (const char*)g.A + (size_t)nxt.pm * tstep + (size_t)nxt.k0 * kstep : cA; const char* nB = has_next ? (const char*)g.Bt + (size_t)nxt.pn * tstep + (size_t)nxt.k0 * kstep : cB;
        const int nt = cur.nt;
        for (int t = 0; t < nt; t += 2) {
            const bool last = (t == nt - 2);
            const char* a1 = cA + (size_t)(t + 1) * kstep;
            const char* a2 = last ? nA : cA + (size_t)(t + 2) * kstep; const char* b2 = last ? nB : cB + (size_t)(t + 2) * kstep;
            const char* a3 = a2 + kstep; const char* b3 = b2 + kstep;
            if (last && has_next) S.a_ready(nxt);
            if constexpr (SP2) {
            PG8_LDB(B0, 0, 0); PG8_LDB(B1, 0, 1); PG8_SCHED; PG8_LDA(At, 0, 0); PG8_STAGE(PG8_SA(1, 1), a1 + hstep, voffA);
            PG8_WAIT_V(8); PG8_WAIT_L(0); PG8_BAR; PG8_MMA(0, 0, At, B0); PG8_MMA(0, 1, At, B1); PG8_BAR; PG8_SCHED;
            PG8_LDA(At, 0, 1); PG8_STAGE(PG8_SB(0, 0), b2, voffB); PG8_STAGE(PG8_SB(0, 1), b2 + hstep, voffB); PG8_STAGE(PG8_SA(0, 0), a2, voffA);
            PG8_WAIT_V(8); PG8_WAIT_L(0); PG8_BAR; PG8_MMA(1, 0, At, B0); PG8_MMA(1, 1, At, B1); PG8_BAR; PG8_SCHED;
            PG8_LDB(B0, 1, 0); PG8_LDB(B1, 1, 1); PG8_SCHED; PG8_LDA(At, 1, 0); PG8_STAGE(PG8_SA(0, 1), a2 + hstep, voffA);
            PG8_WAIT_V(8); PG8_WAIT_L(0); PG8_BAR; PG8_MMA(0, 0, At, B0); PG8_MMA(0, 1, At, B1); PG8_BAR; PG8_SCHED;
            PG8_LDA(At, 1, 1); PG8_STAGE(PG8_SB(1, 0), b3, voffB); PG8_STAGE(PG8_SB(1, 1), b3 + hstep, voffB); PG8_STAGE(PG8_SA(1, 0), a3, voffA);
            PG8_WAIT_V(8); PG8_WAIT_L(0); PG8_BAR; PG8_MMA(1, 0, At, B0); PG8_MMA(1, 1, At, B1); PG8_BAR; PG8_SCHED;
            } else {
            PG8_LDB(B0, 0, 0); PG8_SCHED; PG8_LDA(At, 0, 0); PG8_STAGE(PG8_SA(1, 1), a1 + hstep, voffA);
            PG8_WAIT_L(8); PG8_BAR; PG8_WAIT_L(0); PG8_MMA(0, 0, At, B0); PG8_BAR; PG8_SCHED;
            PG8_LDB(B1, 0, 1); PG8_STAGE(PG8_SB(0, 0), b2, voffB);
            PG8_BAR; PG8_WAIT_L(0); PG8_MMA(0, 1, At, B1); PG8_BAR;
            PG8_LDA(At, 0, 1); PG8_STAGE(PG8_SA(0, 0), a2, voffA);
            PG8_BAR; PG8_WAIT_L(0); PG8_MMA(1, 0, At, B0); PG8_BAR; PG8_SCHED;
            PG8_STAGE(PG8_SB(0, 1), b2 + hstep, voffB);
            PG8_WAIT_V(6); PG8_BAR; PG8_MMA(1, 1, At, B1); PG8_BAR;
            PG8_LDB(B0, 1, 0); PG8_SCHED; PG8_LDA(At, 1, 0); PG8_STAGE(PG8_SA(0, 1), a2 + hstep, voffA);
            PG8_WAIT_L(8); PG8_BAR; PG8_WAIT_L(0); PG8_MMA(0, 0, At, B0); PG8_BAR; PG8_SCHED;
            PG8_LDB(B1, 1, 1); PG8_STAGE(PG8_SB(1, 0), b3, voffB);
            PG8_BAR; PG8_WAIT_L(0); PG8_MMA(0, 1, At, B1); PG8_BAR;
            PG8_LDA(At, 1, 1); PG8_STAGE(PG8_SA(1, 0), a3, voffA);
            PG8_BAR; PG8_WAIT_L(0); PG8_MMA(1, 0, At, B0); PG8_BAR; PG8_SCHED;
            PG8_STAGE(PG8_SB(1, 1), b3 + hstep, voffB);
            PG8_WAIT_V(6); PG8_BAR; PG8_MMA(1, 1, At, B1); PG8_BAR;
            }
        }
        if constexpr (ALIGN_EPI) { if (wr == 0) PG8_BAR; }
        if constexpr (!Epi::AFTER_DRAIN) { E(acc, cur, wr, wc, fr, fq); S.done(cur); }
        if (!has_next) break;
#pragma unroll
        for (int a = 0; a < 2; ++a)
#pragma unroll
            for (int b = 0; b < 2; ++b)
#pragma unroll
                for (int m = 0; m < 4; ++m)
#pragma unroll
                    for (int n = 0; n < 2; ++n) acc[a][b][m][n] = (f32x4){0.f, 0.f, 0.f, 0.f};
        cur = nxt; cA = nA; cB = nB; ++ui;
        if constexpr (ALIGN_EPI) { if (wr == 1) PG8_BAR; }
    }
    PG8_WAIT_V(0);
    if constexpr (!ALIGN_EPI) { if (wr == 0) PG8_BAR; }
    PG8_BAR;
    if constexpr (Epi::AFTER_DRAIN) { E.fused(acc, cur, wr, wc, fr, fq, lds, wid, lane); S.done(cur); }
#undef PG8_SA
#undef PG8_SB
#undef PG8_STAGE
#undef PG8_LDA
#undef PG8_LDB
#undef PG8_MMA
#undef PG8_WAIT_V
#undef PG8_WAIT_L
#undef PG8_BAR
#undef PG8_SCHED
}
}

#define LAS __attribute__((address_space(3)))
typedef unsigned short bf16;
typedef short bf16x8 __attribute__((ext_vector_type(8)));
typedef short s16x4 __attribute__((ext_vector_type(4)));
typedef float f32x4 __attribute__((ext_vector_type(4)));
typedef float f32x16 __attribute__((ext_vector_type(16)));
typedef unsigned u32x4 __attribute__((ext_vector_type(4)));
typedef unsigned u32x2 __attribute__((ext_vector_type(2)));

constexpr int DM = 2048, MP = 8192, MS = 512, MT = MP + MS, INW = 7168, FF = 8192, HW = 1024;
constexpr int NH = 8, NCH_P = 128, NCH = 136, PAST = 4096, KVS = PAST + 64;
constexpr float EPS = 1e-6f;
constexpr float QSCALE = 0.125f * 1.44269504088896340736f;
constexpr float LAM_INIT = 0.2f;

constexpr size_t O_Y = 0, O_KP = (size_t)MT * DM, O_VP = O_KP + (size_t)MP * HW, O_SP = O_VP + (size_t)MP * HW,
                 O_KS = O_SP + (size_t)NH * 128 * 128, O_VS = O_KS + (size_t)MS * HW, O_SS = O_VS + (size_t)MS * HW;
constexpr size_t MiB = 1u << 20;
constexpr size_t WS_SS2 = 0, WS_SS3 = 64 * 1024, WS_BAR = 128 * 1024, WS_BAR_BYTES = 16384, WS_DD = 512 * 1024;
constexpr size_t WS_WOUT = 1 * MiB, WS_WUP = 9 * MiB, WS_WDOWN = 41 * MiB, WS_WIN = 73 * MiB, WS_XN = 101 * MiB;
constexpr size_t WS_STB = 73 * MiB, WS_X2B = 73 * MiB;
constexpr size_t WS_PART = 135 * MiB;
constexpr size_t WS_QG = 135 * MiB, WS_VI = 152 * MiB, WS_GG = 169 * MiB, WS_LOGF = 186 * MiB, WS_MIX = 220 * MiB;
constexpr size_t WS_UT = 254 * MiB, WS_X2 = 254 * MiB, WS_QB = 322 * MiB, WS_KB = 339 * MiB, WS_VB = 356 * MiB;
constexpr size_t WS_AP = 107 * MiB;
constexpr size_t WS_U = 339 * MiB, WS_END = 475 * MiB;
static_assert(WS_U + (size_t)MT * FF * 2 <= WS_END && WS_X2 + (size_t)MT * DM * 4 <= WS_QB && WS_VB + (size_t)MT * HW * 2 <= WS_END, "ws map");

constexpr int LDS_BYTES = 147456;
#ifndef PROBE_MASK
#define PROBE_MASK 0
#endif
#define REP(k) for (int rep_ = 0; rep_ < ((PROBE_MASK >> (k)) & 1) + 1; ++rep_)

struct Args { const float* in[19]; float* out; unsigned char* ws; };

__device__ __forceinline__ float bf2f(unsigned short b) { return __uint_as_float((unsigned)b << 16); }
__device__ __forceinline__ unsigned pk2(float lo, float hi) { return pg8::cvt_pk_bf16(lo, hi); }
__device__ __forceinline__ float wave_sum(float v) {
#pragma unroll
    for (int o = 1; o < 64; o <<= 1) v += __shfl_xor(v, o);
    return v;
}
__device__ __forceinline__ float fexp(float x) { return __builtin_amdgcn_exp2f(x * 1.44269504088896340736f); }
__device__ __forceinline__ float sigm(float x) { return __builtin_amdgcn_rcpf(1.f + fexp(-x)); }
__device__ __forceinline__ int crow(int i, int hh) { return (i & 3) + 8 * (i >> 2) + 4 * hh; }
#define MFMA32(a, b, c) __builtin_amdgcn_mfma_f32_32x32x16_bf16((a), (b), (c), 0, 0, 0)
__device__ __forceinline__ bf16x8 pack8(const f32x16& x, int half) {
    u32x4 p;
    p.x = pk2(x[8 * half + 0], x[8 * half + 1]); p.y = pk2(x[8 * half + 2], x[8 * half + 3]);
    p.z = pk2(x[8 * half + 4], x[8 * half + 5]); p.w = pk2(x[8 * half + 6], x[8 * half + 7]);
    return __builtin_bit_cast(bf16x8, p);
}
__device__ __forceinline__ bf16x8 tr2(const LAS unsigned char* p0, const LAS unsigned char* p1) {
    const s16x4 a = __builtin_amdgcn_ds_read_tr16_b64_v4i16((LAS s16x4*)p0);
    const s16x4 b = __builtin_amdgcn_ds_read_tr16_b64_v4i16((LAS s16x4*)p1);
    return __builtin_shufflevector(a, b, 0, 1, 2, 3, 4, 5, 6, 7);
}


struct SplitOrder {
    pg8::StaticOrder base; int nb, c, G, s_nN, s_splits, s_nt, s_units;
    __device__ void init(int Mp, int N, int G_, int c_, int ntk, int splits) {
        base.init(Mp, N, G_, c_, ntk); G = G_; c = c_;
        nb = c_ < base.nwg ? (base.nwg - c_ + G_ - 1) / G_ : 0;
        s_nN = N / 256; s_splits = splits; s_nt = ntk / splits; s_units = 2 * s_nN * splits;
    }
    __device__ bool next(int i, pg8::Unit& u) const {
        if (i < nb) return base.next(i, u);
        const int L = (i - nb) * G + c; if (L >= s_units) return false;
        const int tile = L / s_splits, j = L % s_splits;
        u.pm = 32 + tile / s_nN; u.pn = tile % s_nN; u.k0 = j * s_nt; u.nt = s_nt; u.kind = 1 + j; return true;
    }
    __device__ __forceinline__ void a_ready(const pg8::Unit&) const {}
    __device__ __forceinline__ void done(const pg8::Unit&) const {}
};
__device__ __forceinline__ void store_partial(const pg8::f32x4 (&acc)[2][2][4][2], const pg8::Unit& u, int wr, int wc, int fr, int fq, float* PART, int N) {
    const int cbase = u.pn * 256 + wc * 32 + fq * 4, rbase = (u.pm - 32) * 256 + wr * 64 + fr;
    float* P = PART + (size_t)(u.kind - 1) * 512 * N;
#pragma unroll
    for (int ai = 0; ai < 2; ++ai)
#pragma unroll
        for (int m = 0; m < 4; ++m)
#pragma unroll
            for (int bj = 0; bj < 2; ++bj)
#pragma unroll
                for (int n = 0; n < 2; ++n) *(pg8::f32x4*)(P + (size_t)(rbase + ai * 128 + m * 16) * N + cbase + bj * 128 + n * 16) = acc[ai][bj][m][n];
}

struct Epi1 {
    static constexpr bool PERM = false, AFTER_DRAIN = false;
    bf16 *QG, *VI, *GG, *QB, *KB, *VB; float* LOGF; float* out; const float* lbw;
    __device__ __forceinline__ void operator()(const f32x4 (&acc)[2][2][4][2], const pg8::Unit& u, int wr, int wc, int fr, int fq) const {
        const int region = u.pn >> 2;
        const int cbase = (u.pn & 3) * 256 + wc * 32 + fq * 4;
        const int rbase = u.pm * 256 + wr * 64 + fr;
        if (region == 1) {
            f32x4 lb[2][2];
#pragma unroll
            for (int bj = 0; bj < 2; ++bj)
#pragma unroll
                for (int n = 0; n < 2; ++n) { const int c = cbase + bj * 128 + n * 16; const f32x4 l0 = *(const f32x4*)(lbw + c), l1 = *(const f32x4*)(lbw + HW + c);
#pragma unroll
                    for (int j = 0; j < 4; ++j) lb[bj][n][j] = 1.f / (1.f + __expf(l1[j] - l0[j])); }
#pragma unroll
            for (int ai = 0; ai < 2; ++ai)
#pragma unroll
                for (int m = 0; m < 4; ++m) { const size_t row = rbase + ai * 128 + m * 16;
#pragma unroll
                    for (int bj = 0; bj < 2; ++bj)
#pragma unroll
                        for (int n = 0; n < 2; ++n) { const f32x4 v = acc[ai][bj][m][n]; f32x4 o;
#pragma unroll
                            for (int j = 0; j < 4; ++j) { const float l = lb[bj][n][j]; o[j] = logf(l + (1.f - l) * sigm(v[j])); }
                            *(f32x4*)(LOGF + row * HW + cbase + bj * 128 + n * 16) = o; } }
        } else if (region <= 4) {
            bf16* dst = region == 0 ? QG : (region == 2 ? VI : (region == 3 ? GG : QB));
#pragma unroll
            for (int ai = 0; ai < 2; ++ai)
#pragma unroll
                for (int m = 0; m < 4; ++m) { const size_t row = rbase + ai * 128 + m * 16;
#pragma unroll
                    for (int bj = 0; bj < 2; ++bj)
#pragma unroll
                        for (int n = 0; n < 2; ++n) { f32x4 v = acc[ai][bj][m][n];
                            if (region == 0 || region == 3) {
#pragma unroll
                                for (int j = 0; j < 4; ++j) v[j] = v[j] * sigm(v[j]);
                            } else if (region == 4) v = v * QSCALE;
                            u32x2 w; w.x = pk2(v[0], v[1]); w.y = pk2(v[2], v[3]);
                            *(u32x2*)(dst + row * HW + cbase + bj * 128 + n * 16) = w; } }
        } else {
            const bool isk = region == 5; const bool prompt = u.pm < 32;
#pragma unroll
            for (int ai = 0; ai < 2; ++ai)
#pragma unroll
                for (int m = 0; m < 4; ++m) { const int row = rbase + ai * 128 + m * 16;
                    float* of;
                    bf16* ob = (isk ? KB : VB) + (size_t)row * HW;
                    if (prompt) of = out + (isk ? O_KP : O_VP) + (size_t)row * HW; else of = out + (isk ? O_KS : O_VS) + (size_t)(row - MP) * HW;
#pragma unroll
                    for (int bj = 0; bj < 2; ++bj)
#pragma unroll
                        for (int n = 0; n < 2; ++n) { const f32x4 v = acc[ai][bj][m][n]; const int c = cbase + bj * 128 + n * 16;
                            *(f32x4*)(of + c) = v; u32x2 w; w.x = pk2(v[0], v[1]); w.y = pk2(v[2], v[3]); *(u32x2*)(ob + c) = w; } }
        }
    }
};
struct Epi2 {
    static constexpr bool PERM = false, AFTER_DRAIN = false;
    const float *xp, *xs; float* X2; bf16* X2B; float* SS; float* PART;
    __device__ __forceinline__ void operator()(const f32x4 (&acc)[2][2][4][2], const pg8::Unit& u, int wr, int wc, int fr, int fq) const {
        if (u.kind) { store_partial(acc, u, wr, wc, fr, fq, PART, DM); return; }
        const int cbase = u.pn * 256 + wc * 32 + fq * 4, rbase = u.pm * 256 + wr * 64 + fr;
        const float* xin = u.pm < 32 ? xp : xs - (size_t)MP * DM;
#pragma unroll
        for (int ai = 0; ai < 2; ++ai)
#pragma unroll
            for (int m = 0; m < 4; ++m) { const size_t row = rbase + ai * 128 + m * 16; float ss = 0.f;
#pragma unroll
                for (int bj = 0; bj < 2; ++bj)
#pragma unroll
                    for (int n = 0; n < 2; ++n) { const size_t off = row * DM + cbase + bj * 128 + n * 16;
                        const f32x4 v = acc[ai][bj][m][n] + *(const f32x4*)(xin + off);
                        ss += (v[0] * v[0] + v[1] * v[1]) + (v[2] * v[2] + v[3] * v[3]);
                        *(f32x4*)(X2 + off) = v; u32x2 w; w.x = pk2(v[0], v[1]); w.y = pk2(v[2], v[3]); *(u32x2*)(X2B + off) = w; }
                ss += __shfl_xor(ss, 16); ss += __shfl_xor(ss, 32);
                if (fq == 0) atomicAdd(SS + row, ss); }
    }
};
struct Epi3 {
    static constexpr bool PERM = false, AFTER_DRAIN = false;
    bf16* U; const float* SS; float* PART;
    __device__ __forceinline__ void operator()(const f32x4 (&acc)[2][2][4][2], const pg8::Unit& u, int wr, int wc, int fr, int fq) const {
        if (u.kind) { store_partial(acc, u, wr, wc, fr, fq, PART, FF); return; }
        const int cbase = u.pn * 256 + wc * 32 + fq * 4, rbase = u.pm * 256 + wr * 64 + fr;
#pragma unroll
        for (int ai = 0; ai < 2; ++ai)
#pragma unroll
            for (int m = 0; m < 4; ++m) { const size_t row = rbase + ai * 128 + m * 16;
                const float rstd = __builtin_amdgcn_rsqf(__hip_atomic_load(SS + row, __ATOMIC_RELAXED, __HIP_MEMORY_SCOPE_AGENT) * (1.f / DM) + EPS);
#pragma unroll
                for (int bj = 0; bj < 2; ++bj)
#pragma unroll
                    for (int n = 0; n < 2; ++n) { f32x4 v = acc[ai][bj][m][n] * rstd;
#pragma unroll
                        for (int j = 0; j < 4; ++j) { const float t = fmaxf(v[j], 0.f); v[j] = t * t; }
                        u32x2 w; w.x = pk2(v[0], v[1]); w.y = pk2(v[2], v[3]); *(u32x2*)(U + row * FF + cbase + bj * 128 + n * 16) = w; } }
    }
};
struct Epi4 {
    static constexpr bool PERM = false, AFTER_DRAIN = false;
    const float* X2; float* Y; float* PART;
    __device__ __forceinline__ void operator()(const f32x4 (&acc)[2][2][4][2], const pg8::Unit& u, int wr, int wc, int fr, int fq) const {
        if (u.kind) { store_partial(acc, u, wr, wc, fr, fq, PART, DM); return; }
        const int cbase = u.pn * 256 + wc * 32 + fq * 4, rbase = u.pm * 256 + wr * 64 + fr;
#pragma unroll
        for (int ai = 0; ai < 2; ++ai)
#pragma unroll
            for (int m = 0; m < 4; ++m) { const size_t row = rbase + ai * 128 + m * 16;
#pragma unroll
                for (int bj = 0; bj < 2; ++bj)
#pragma unroll
                    for (int n = 0; n < 2; ++n) { const size_t off = row * DM + cbase + bj * 128 + n * 16;
                        *(f32x4*)(Y + off) = acc[ai][bj][m][n] + *(const f32x4*)(X2 + off); } }
    }
};

__device__ __forceinline__ void p0_transpose_item(const float* W, int K, int N, bf16* WT, const float* gain, LAS float* scr, int item, int lane) {
    const int nblk = N / 32, kb = item / nblk, nb = item % nblk, k0 = 64 * kb, n0 = 32 * nb;
#pragma unroll 8
    for (int i = 0; i < 32; ++i) { const int kk = 2 * i + (lane >> 5); float v = W[(size_t)(k0 + kk) * N + n0 + (lane & 31)]; if (gain) v *= gain[k0 + kk]; scr[kk * 33 + (lane & 31)] = v; }
    asm volatile("s_waitcnt lgkmcnt(0)" ::: "memory");
    const int c = lane & 7;
#pragma unroll
    for (int j = 0; j < 4; ++j) { const int n = (lane >> 3) + 8 * j; const LAS float* s = scr + (8 * c) * 33 + n;
        u32x4 o; o.x = pk2(s[0 * 33], s[1 * 33]); o.y = pk2(s[2 * 33], s[3 * 33]); o.z = pk2(s[4 * 33], s[5 * 33]); o.w = pk2(s[6 * 33], s[7 * 33]);
        *(u32x4*)(WT + (size_t)(n0 + n) * K + k0 + 8 * c) = o; }
    asm volatile("s_waitcnt lgkmcnt(0)" ::: "memory");
}

constexpr int A_KP = 272, A_VP = 320, A_KB = 64 * A_KP, A_VB = 64 * A_VP, A_STG = A_KB + A_VB, A_XOFF = 2 * A_STG, A_XP = 132;
static_assert(A_XOFF + 128 * A_XP * 4 <= LDS_BYTES - 64, "attention LDS");
__device__ __forceinline__ void attn_step(const LAS unsigned char* sb, int kaddr, int vaddr, const bf16x8 (&qf)[4], f32x16 (&o)[4], float& m_run, float& l_run, bool& rebased) {
#define A_VLOAD(V, ks) do { _Pragma("unroll") for (int dt = 0; dt < 4; ++dt) { const LAS unsigned char* va_ = sb + vaddr + (16 * (ks)) * A_VP + dt * 64; V[dt] = tr2(va_, va_ + 8 * A_VP); } } while (0)
#define A_PV(V, P) do { _Pragma("unroll") for (int dt = 0; dt < 4; ++dt) o[dt] = MFMA32(V[dt], P, o[dt]); } while (0)
#define A_SB() __builtin_amdgcn_sched_barrier(0)
    bf16x8 k0[4], k1[4];
#pragma unroll
    for (int s = 0; s < 4; ++s) { k0[s] = *(const LAS bf16x8*)(sb + kaddr + 32 * s); k1[s] = *(const LAS bf16x8*)(sb + kaddr + 32 * A_KP + 32 * s); }
    A_SB();
    f32x16 s0, s1;
#pragma unroll
    for (int i = 0; i < 16; ++i) { s0[i] = 0.f; s1[i] = 0.f; }
#pragma unroll
    for (int s = 0; s < 4; ++s) { s0 = MFMA32(k0[s], qf[s], s0); s1 = MFMA32(k1[s], qf[s], s1); }
    bf16x8 va[4], vb[4];
    A_VLOAD(va, 0);
    A_SB();
    float mx = __builtin_fmaxf(s0[0], s1[0]);
#pragma unroll
    for (int i = 1; i < 16; ++i) mx = __builtin_fmaxf(mx, __builtin_fmaxf(s0[i], s1[i]));
    mx = __builtin_fmaxf(mx, __shfl_xor(mx, 32));
    if (rebased) {
#pragma unroll
        for (int i = 0; i < 16; ++i) { s0[i] -= m_run; s1[i] -= m_run; }
        mx -= m_run;
    }
    const bool need = (mx > 32.f) || (mx < -64.f);
    if (__any(need)) {
        const float d = need ? mx : 0.f, alpha = __builtin_amdgcn_exp2f(-d);
        m_run += d; l_run *= alpha;
#pragma unroll
        for (int i = 0; i < 16; ++i) { s0[i] -= d; s1[i] -= d; }
#pragma unroll
        for (int dt = 0; dt < 4; ++dt) o[dt] = o[dt] * alpha;
        rebased = true;
    }
    float ls = 0.f;
#pragma unroll
    for (int i = 0; i < 16; ++i) { s0[i] = __builtin_amdgcn_exp2f(s0[i]); s1[i] = __builtin_amdgcn_exp2f(s1[i]); ls += s0[i] + s1[i]; }
    l_run += ls;
    bf16x8 pf[4]; pf[0] = pack8(s0, 0); pf[1] = pack8(s0, 1); pf[2] = pack8(s1, 0); pf[3] = pack8(s1, 1);
    A_SB();
    A_VLOAD(vb, 1); A_SB(); A_PV(va, pf[0]); A_SB();
    A_VLOAD(va, 2); A_SB(); A_PV(vb, pf[1]); A_SB();
    A_VLOAD(vb, 3); A_SB(); A_PV(va, pf[2]); A_SB();
    A_PV(vb, pf[3]);
#undef A_VLOAD
#undef A_PV
#undef A_SB
}

__device__ __forceinline__ void attn_unit(LAS unsigned char* lds, const bf16* qp, const bf16* kp, const bf16* vp, int ntiles,
                                          bf16* op, float lam, const float* subln, int tid, int wave, int lane) {
    const int c = wave >> 2, qt = wave & 3, r = lane & 31, hh = lane >> 5;
    const int myt = ntiles - (qt < 2 ? 1 : 0);
    bf16x8 qf[4];
    { const bf16* q = qp + (size_t)(qt * 32 + r) * HW + c * 64 + 8 * hh;
#pragma unroll
      for (int s = 0; s < 4; ++s) qf[s] = *(const bf16x8*)(q + 16 * s); }
    const int key0 = tid >> 4, ch = tid & 15;
    const size_t g0 = (size_t)key0 * HW + ch * 8, g1 = g0 + (size_t)32 * HW;
    const int lk0 = key0 * A_KP + ch * 16, lk1 = lk0 + 32 * A_KP, lv0 = A_KB + key0 * A_VP + ch * 16, lv1 = lv0 + 32 * A_VP;
    u32x4 sa0, sa1, sa2, sa3, sb0, sb1, sb2, sb3;
#define A_GLOAD(S, t) do { const size_t tb = (size_t)(t) * 64 * HW; S##0 = *(const u32x4*)(kp + tb + g0); S##1 = *(const u32x4*)(kp + tb + g1); S##2 = *(const u32x4*)(vp + tb + g0); S##3 = *(const u32x4*)(vp + tb + g1); } while (0)
#define A_LSTORE(S, b) do { LAS unsigned char* sb_ = lds + (b) * A_STG; *(LAS u32x4*)(sb_ + lk0) = S##0; *(LAS u32x4*)(sb_ + lk1) = S##1; *(LAS u32x4*)(sb_ + lv0) = S##2; *(LAS u32x4*)(sb_ + lv1) = S##3; } while (0)
    f32x16 o[4];
#pragma unroll
    for (int dt = 0; dt < 4; ++dt)
#pragma unroll
        for (int i = 0; i < 16; ++i) o[dt][i] = 0.f;
    float m_run = 0.f, l_run = 0.f; bool rebased = false;
    const int kaddr = r * A_KP + c * 128 + 16 * hh;
    const int g16 = (lane >> 4) & 1, i16 = lane & 15, tq = i16 >> 2, tp = i16 & 3;
    const int vaddr = A_KB + (4 * hh + tq) * A_VP + (g16 * 16 + 4 * tp) * 2;
    A_GLOAD(sa, 0); A_GLOAD(sb, 1); A_LSTORE(sa, 0); __syncthreads();
    for (int t = 0; t < ntiles; t += 2) {
        if (t + 2 < ntiles) A_GLOAD(sa, t + 2);
        if (t < myt) attn_step(lds, kaddr, vaddr, qf, o, m_run, l_run, rebased);
        A_LSTORE(sb, 1);
        __syncthreads();
        if (t + 3 < ntiles) A_GLOAD(sb, t + 3);
        if (t + 1 < myt) attn_step(lds + A_STG, kaddr, vaddr, qf, o, m_run, l_run, rebased);
        if (t + 2 < ntiles) A_LSTORE(sa, 0);
        __syncthreads();
    }
#undef A_GLOAD
#undef A_LSTORE
    const float lt = l_run + __shfl_xor(l_run, 32);
    const float inv = 1.f / lt;
    LAS float* X = (LAS float*)(lds + A_XOFF);
    if (c == 1) {
#pragma unroll
        for (int dt = 0; dt < 4; ++dt)
#pragma unroll
            for (int g = 0; g < 4; ++g) { f32x4 v; v[0] = o[dt][4 * g] * inv; v[1] = o[dt][4 * g + 1] * inv; v[2] = o[dt][4 * g + 2] * inv; v[3] = o[dt][4 * g + 3] * inv;
                *(LAS f32x4*)(X + (qt * 32 + r) * A_XP + dt * 32 + 8 * g + 4 * hh) = v; }
    }
    __syncthreads();
    if (c == 0) {
        float ssq = 0.f;
#pragma unroll
        for (int dt = 0; dt < 4; ++dt)
#pragma unroll
            for (int g = 0; g < 4; ++g) { const f32x4 x2 = *(const LAS f32x4*)(X + (qt * 32 + r) * A_XP + dt * 32 + 8 * g + 4 * hh);
#pragma unroll
                for (int j = 0; j < 4; ++j) { const float v = o[dt][4 * g + j] * inv - lam * x2[j]; o[dt][4 * g + j] = v; ssq += v * v; } }
        ssq += __shfl_xor(ssq, 32);
        const float rms = __builtin_amdgcn_rsqf(ssq * (1.f / 128.f) + EPS) * (1.f - LAM_INIT);
        bf16* orow = op + (size_t)(qt * 32 + r) * DM;
#pragma unroll
        for (int dt = 0; dt < 4; ++dt)
#pragma unroll
            for (int g = 0; g < 4; ++g) { const int dv = dt * 32 + 8 * g + 4 * hh; const f32x4 w = *(const f32x4*)(subln + dv);
                u32x2 pw; pw.x = pk2(o[dt][4 * g] * rms * w[0], o[dt][4 * g + 1] * rms * w[1]); pw.y = pk2(o[dt][4 * g + 2] * rms * w[2], o[dt][4 * g + 3] * rms * w[3]);
                *(u32x2*)(orow + dv) = pw; }
    }
}

constexpr int AP_ROW = 132, AP_MAP = 64 * AP_ROW;
__device__ __forceinline__ void attn_unit_s(LAS unsigned char* lds, const bf16* qp, const float* ck, const float* cv, int t0, int nc, bool has_new, const float* kn, const float* vn,
                                            float* ap, int tid, int wave, int lane) {
    const int c = wave >> 2, qt = wave & 3, r = lane & 31, hh = lane >> 5;
    const int ntiles = nc + (has_new ? 1 : 0);
    if (qt < 2) {
        bf16x8 qf[4];
        { const bf16* q = qp + (size_t)(qt * 32 + r) * HW + c * 64 + 8 * hh;
#pragma unroll
          for (int s = 0; s < 4; ++s) qf[s] = *(const bf16x8*)(q + 16 * s); }
        f32x16 o[4];
#pragma unroll
        for (int dt = 0; dt < 4; ++dt)
#pragma unroll
            for (int i = 0; i < 16; ++i) o[dt][i] = 0.f;
        float m_run = 0.f, l_run = 0.f; bool rebased = false;
        const int kaddr = r * A_KP + c * 128 + 16 * hh;
        const int g16 = (lane >> 4) & 1, i16 = lane & 15, tq = i16 >> 2, tp = i16 & 3;
        const int vaddr = A_KB + (4 * hh + tq) * A_VP + (g16 * 16 + 4 * tp) * 2;
        __syncthreads();
        for (int t = 0; t < ntiles; ++t) {
            attn_step(lds + (t & 1) * A_STG, kaddr, vaddr, qf, o, m_run, l_run, rebased);
            __syncthreads();
        }
        const float lt = l_run + __shfl_xor(l_run, 32);
        float* row = ap + (size_t)c * AP_MAP + (size_t)(qt * 32 + r) * AP_ROW;
#pragma unroll
        for (int dt = 0; dt < 4; ++dt)
#pragma unroll
            for (int g = 0; g < 4; ++g) { f32x4 v; v[0] = o[dt][4 * g]; v[1] = o[dt][4 * g + 1]; v[2] = o[dt][4 * g + 2]; v[3] = o[dt][4 * g + 3];
                *(f32x4*)(row + dt * 32 + 8 * g + 4 * hh) = v; }
        if (hh == 0) { row[128] = m_run; row[129] = lt; }
    } else {
        const int lt = c * 128 + (qt & 1) * 64 + lane;
        const int key0 = lt >> 4, ch = lt & 15;
        const size_t g0 = (size_t)key0 * HW + ch * 8;
        const int lk = key0 * A_KP + ch * 16, lv = A_KB + key0 * A_VP + ch * 16;
        f32x4 fa[16], fb[16];
#define S_TILE(i, P) ((i) < nc ? (P == 0 ? ck : cv) + (size_t)(t0 + (i)) * 64 * HW : (P == 0 ? kn : vn))
#define S_LOAD(F, i) do { const float* kp_ = S_TILE(i, 0) + g0; const float* vp_ = S_TILE(i, 1) + g0; \
        _Pragma("unroll") for (int j = 0; j < 4; ++j) { F[2 * j] = *(const f32x4*)(kp_ + (size_t)j * 16 * HW); F[2 * j + 1] = *(const f32x4*)(kp_ + (size_t)j * 16 * HW + 4); \
                                                        F[8 + 2 * j] = *(const f32x4*)(vp_ + (size_t)j * 16 * HW); F[8 + 2 * j + 1] = *(const f32x4*)(vp_ + (size_t)j * 16 * HW + 4); } } while (0)
#define S_PK(a, b) ((u32x4){pk2((a)[0], (a)[1]), pk2((a)[2], (a)[3]), pk2((b)[0], (b)[1]), pk2((b)[2], (b)[3])})
#define S_STORE(F, b) do { LAS unsigned char* sb_ = lds + (b) * A_STG; \
        _Pragma("unroll") for (int j = 0; j < 4; ++j) { *(LAS u32x4*)(sb_ + lk + j * 16 * A_KP) = S_PK(F[2 * j], F[2 * j + 1]); *(LAS u32x4*)(sb_ + lv + j * 16 * A_VP) = S_PK(F[8 + 2 * j], F[8 + 2 * j + 1]); } } while (0)
        S_LOAD(fa, 0);
        if (ntiles > 1) S_LOAD(fb, 1);
        S_STORE(fa, 0);
        __syncthreads();
        for (int t = 0; t < ntiles; t += 2) {
            if (t + 2 < ntiles) S_LOAD(fa, t + 2);
            if (t + 1 < ntiles) S_STORE(fb, 1);
            __syncthreads();
            if (t + 1 >= ntiles) break;
            if (t + 3 < ntiles) S_LOAD(fb, t + 3);
            if (t + 2 < ntiles) S_STORE(fa, 0);
            __syncthreads();
        }
#undef S_TILE
#undef S_LOAD
#undef S_PK
#undef S_STORE
    }
}

__device__ __forceinline__ void gla1_item(LAS unsigned char* lds, int ci, int h, const bf16* VI, const float* LOGF, float* UT, float* DD, bf16* STB,
                                          const float* state_in, float* state_out, int tid, int wave, int lane) {
    const int m0 = ci * 64;
#pragma unroll
    for (int i = 0; i < 2; ++i) { const int id = tid + 512 * i, key = id >> 4, ch = id & 15;
        *(LAS u32x4*)(lds + key * A_VP + ch * 16) = *(const u32x4*)(VI + (size_t)(m0 + key) * HW + h * 128 + ch * 8); }
    const int ct = wave & 3, dh = wave >> 2, r = lane & 31, hh = lane >> 5, k = ct * 32 + r;
    float lf[64];
    { const float* p = LOGF + (size_t)m0 * HW + h * 128 + k;
#pragma unroll
      for (int t = 0; t < 64; ++t) lf[t] = p[(size_t)t * HW]; }
    float suf = 0.f;
#pragma unroll
    for (int tt = 0; tt < 64; ++tt) { const float l = lf[63 - tt]; lf[63 - tt] = (1.f - fexp(l)) * fexp(suf); suf += l; }
    const float d = fexp(suf);
    bf16x8 kf[4];
#pragma unroll
    for (int ks = 0; ks < 4; ++ks) { u32x4 p;
        const unsigned a0 = pk2(lf[16 * ks + 0], lf[16 * ks + 1]), a1 = pk2(lf[16 * ks + 2], lf[16 * ks + 3]), a2 = pk2(lf[16 * ks + 4], lf[16 * ks + 5]), a3 = pk2(lf[16 * ks + 6], lf[16 * ks + 7]);
        const unsigned b0 = pk2(lf[16 * ks + 8], lf[16 * ks + 9]), b1 = pk2(lf[16 * ks + 10], lf[16 * ks + 11]), b2 = pk2(lf[16 * ks + 12], lf[16 * ks + 13]), b3 = pk2(lf[16 * ks + 14], lf[16 * ks + 15]);
        p.x = hh ? b0 : a0; p.y = hh ? b1 : a1; p.z = hh ? b2 : a2; p.w = hh ? b3 : a3;
        kf[ks] = __builtin_bit_cast(bf16x8, p); }
    __syncthreads();
    const int g16 = (lane >> 4) & 1, i16 = lane & 15, tq = i16 >> 2, tp = i16 & 3;
    const int vaddr = (8 * hh + tq) * A_VP + (g16 * 16 + 4 * tp) * 2;
    f32x16 acc[2];
#pragma unroll
    for (int e = 0; e < 2; ++e)
#pragma unroll
        for (int i = 0; i < 16; ++i) acc[e][i] = 0.f;
#pragma unroll
    for (int ks = 0; ks < 4; ++ks)
#pragma unroll
        for (int e = 0; e < 2; ++e) { const LAS unsigned char* va = lds + vaddr + (16 * ks) * A_VP + (2 * dh + e) * 64;
            const bf16x8 vf = tr2(va, va + 4 * A_VP);
            acc[e] = MFMA32(vf, kf[ks], acc[e]); }
    if (ci < NCH_P) {
        float* ut = UT + (size_t)(ci * NH + h) * 16384;
#pragma unroll
        for (int e = 0; e < 2; ++e)
#pragma unroll
            for (int i = 0; i < 16; ++i) ut[((2 * dh + e) * 32 + crow(i, hh)) * 128 + k] = acc[e][i];
        if (dh == 0 && hh == 0) DD[(ci * NH + h) * 128 + k] = d;
    } else {
        const int b = ci - NCH_P; const size_t sb = ((size_t)(b * NH + h) * 128 + k) * 128;
        bf16* stb = STB + (size_t)(ci * NH + h) * 16384;
#pragma unroll
        for (int e = 0; e < 2; ++e)
#pragma unroll
            for (int g = 0; g < 4; ++g) { const int dv0 = (2 * dh + e) * 32 + 8 * g + 4 * hh; const f32x4 s0 = *(const f32x4*)(state_in + sb + dv0); f32x4 o;
#pragma unroll
                for (int j = 0; j < 4; ++j) { o[j] = d * s0[j] + acc[e][4 * g + j]; stb[(dv0 + j) * 128 + k] = (bf16)(pk2(s0[j], 0.f) & 0xffffu); }
                *(f32x4*)(state_out + sb + dv0) = o; }
    }
    __syncthreads();
}

constexpr int G_QT = 0, G_KT = 64 * A_KP, G_VT = 2 * 64 * A_KP, G_PS = G_VT + 64 * A_VP, G_RS = G_PS + 2048;
__device__ __forceinline__ void gla3_item(LAS unsigned char* lds, int ci, int h, const bf16* QG, const bf16* VI, const bf16* GG, const float* LOGF, const bf16* STB,
                                          const float* hgn, bf16* MIX, int tid, int wave, int lane) {
    const int m0 = ci * 64;
#pragma unroll
    for (int i = 0; i < 2; ++i) { const int id = tid + 512 * i, key = id >> 4, ch = id & 15;
        *(LAS u32x4*)(lds + G_VT + key * A_VP + ch * 16) = *(const u32x4*)(VI + (size_t)(m0 + key) * HW + h * 128 + ch * 8); }
    {
        const int k = tid & 127, q4 = tid >> 7;
        const size_t base = (size_t)(m0 + q4 * 16) * HW + h * 128 + k;
        float lf[16], qg[16]; float ps = 0.f;
#pragma unroll
        for (int i = 0; i < 16; ++i) { lf[i] = LOGF[base + (size_t)i * HW]; qg[i] = bf2f(QG[base + (size_t)i * HW]); ps += lf[i]; }
        LAS float* PS = (LAS float*)(lds + G_PS);
        PS[q4 * 128 + k] = ps;
        __syncthreads();
        float b = 0.f;
#pragma unroll
        for (int j = 0; j < 3; ++j) if (j < q4) b += PS[j * 128 + k];
#pragma unroll
        for (int i = 0; i < 16; ++i) { b += lf[i]; const float qv = qg[i] * fexp(b), kv = (1.f - fexp(lf[i])) * fexp(-b);
            const int t = q4 * 16 + i;
            *(LAS bf16*)(lds + G_QT + t * A_KP + k * 2) = (bf16)(pk2(qv, 0.f) & 0xffffu);
            *(LAS bf16*)(lds + G_KT + t * A_KP + k * 2) = (bf16)(pk2(kv, 0.f) & 0xffffu); }
    }
    __syncthreads();
    const int vt = wave & 3, tt = wave >> 2, r = lane & 31, hh = lane >> 5;
    bf16x8 qf[8];
#pragma unroll
    for (int ks = 0; ks < 8; ++ks) qf[ks] = *(const LAS bf16x8*)(lds + G_QT + (tt * 32 + r) * A_KP + (16 * ks + 8 * hh) * 2);
    f32x16 acc;
#pragma unroll
    for (int i = 0; i < 16; ++i) acc[i] = 0.f;
    { const bf16* sp = STB + (size_t)(ci * NH + h) * 16384 + (size_t)(vt * 32 + r) * 128 + 8 * hh;
#pragma unroll
      for (int ks = 0; ks < 8; ++ks) { const bf16x8 sf = *(const bf16x8*)(sp + 16 * ks); acc = MFMA32(sf, qf[ks], acc); } }
    const int g16 = (lane >> 4) & 1, i16 = lane & 15, tq = i16 >> 2, tp = i16 & 3;
    const int vaddr = G_VT + (4 * hh + tq) * A_VP + (vt * 32 + g16 * 16 + 4 * tp) * 2;
#pragma unroll
    for (int st = 0; st < 2; ++st) {
        if (st <= tt) {
            f32x16 a;
#pragma unroll
            for (int i = 0; i < 16; ++i) a[i] = 0.f;
#pragma unroll
            for (int ks = 0; ks < 8; ++ks) { const bf16x8 kf = *(const LAS bf16x8*)(lds + G_KT + (st * 32 + r) * A_KP + (16 * ks + 8 * hh) * 2); a = MFMA32(kf, qf[ks], a); }
            if (st == tt) {
#pragma unroll
                for (int i = 0; i < 16; ++i) if (crow(i, hh) > r) a[i] = 0.f;
            }
            const bf16x8 p0 = pack8(a, 0), p1 = pack8(a, 1);
            const LAS unsigned char* va = lds + vaddr + (st * 32) * A_VP;
            acc = MFMA32(tr2(va, va + 8 * A_VP), p0, acc);
            acc = MFMA32(tr2(va + 16 * A_VP, va + 24 * A_VP), p1, acc);
        }
    }
    float ssq = 0.f;
#pragma unroll
    for (int i = 0; i < 16; ++i) ssq += acc[i] * acc[i];
    ssq += __shfl_xor(ssq, 32);
    LAS float* RS = (LAS float*)(lds + G_RS);
    if (hh == 0) RS[(tt * 4 + vt) * 32 + r] = ssq;
    __syncthreads();
    const float tot = (RS[(tt * 4 + 0) * 32 + r] + RS[(tt * 4 + 1) * 32 + r]) + (RS[(tt * 4 + 2) * 32 + r] + RS[(tt * 4 + 3) * 32 + r]);
    const float rstd = __builtin_amdgcn_rsqf(tot * (1.f / 128.f) + EPS);
    const size_t row = (size_t)(m0 + tt * 32 + r);
#pragma unroll
    for (int g = 0; g < 4; ++g) { const int dv0 = vt * 32 + 8 * g + 4 * hh; const f32x4 w = *(const f32x4*)(hgn + dv0);
        const u32x2 gg = *(const u32x2*)(GG + row * HW + h * 128 + dv0);
        const float g0 = __uint_as_float(gg.x << 16), g1 = __uint_as_float(gg.x & 0xffff0000u), g2 = __uint_as_float(gg.y << 16), g3 = __uint_as_float(gg.y & 0xffff0000u);
        u32x2 pw; pw.x = pk2(acc[4 * g] * rstd * w[0] * g0, acc[4 * g + 1] * rstd * w[1] * g1); pw.y = pk2(acc[4 * g + 2] * rstd * w[2] * g2, acc[4 * g + 3] * rstd * w[3] * g3);
        *(u32x2*)(MIX + row * DM + h * 128 + dv0) = pw; }
    __syncthreads();
}

#define XB_TMO      128
#define XB_XCNT(j)  (256  + 64 * (j))
#define XB_XSUB(j)  (1280 + 64 * (j))
#define XB_XGEN(j)  (2304 + 64 * (j))
#define XB_TOP      3328
#define XB_TOPGEN   3392
#define XCD_BAR_WORDS 3456
#define XB_SPIN_CAP (1u << 18)

__device__ __forceinline__ unsigned xb_ld(unsigned* p)              { return __hip_atomic_load(p, __ATOMIC_RELAXED, __HIP_MEMORY_SCOPE_AGENT); }
__device__ __forceinline__ unsigned xb_add(unsigned* p, unsigned v) { return __hip_atomic_fetch_add(p, v, __ATOMIC_RELAXED, __HIP_MEMORY_SCOPE_AGENT); }
__device__ __forceinline__ unsigned xb_xcc_id() { return (unsigned)__builtin_amdgcn_s_getreg((3 << 11) | 20) & 0xFu; }
#define XB_SPIN(cond, bar) do { unsigned _sp = 0; while (cond) { __builtin_amdgcn_s_sleep(1); \
    if ((++_sp & 255u) == 0u) { if (xb_ld(&(bar)[XB_TMO])) break; if (_sp > XB_SPIN_CAP) { atomicAdd(&(bar)[XB_TMO], 1u); break; } } } } while (0)

struct XcdBarrier {
    unsigned* bar; unsigned x;
    volatile LAS unsigned* st;
};

__device__ __forceinline__ XcdBarrier xcd_barrier_post(unsigned* bar, volatile LAS unsigned* st) {
    XcdBarrier b; b.bar = bar; b.x = xb_xcc_id(); b.st = st;
    if (threadIdx.x == 0) (void)xb_add(&bar[XB_XCNT(b.x)], 1u);
    return b;
}
__device__ __forceinline__ void xcd_barrier_complete(unsigned* bar, unsigned x, unsigned& nloc, unsigned& nx) {
    const unsigned G = gridDim.x * gridDim.y * gridDim.z;
    unsigned sum, cnt, mine, sp = 0u;
    for (;;) {
        sum = 0u; cnt = 0u; mine = 0u;
#pragma unroll
        for (unsigned j = 0; j < 16; ++j) { const unsigned c = xb_ld(&bar[XB_XCNT(j)]); sum += c; cnt += (c > 0u) ? 1u : 0u; mine = (j == x) ? c : mine; }
        if (sum == G) break;
        __builtin_amdgcn_s_sleep(1);
        if ((++sp & 255u) == 0u) { if (xb_ld(&bar[XB_TMO])) break; if (sp > XB_SPIN_CAP) { atomicAdd(&bar[XB_TMO], 1u); break; } }
    }
    nloc = mine > 0u ? mine : 1u; nx = cnt > 0u ? cnt : 1u;
}

__device__ __forceinline__ void xcd_barrier(const XcdBarrier& b) {
    asm volatile("s_waitcnt vmcnt(0)" ::: "memory");
    __syncthreads();
    if (threadIdx.x == 0) {
        unsigned* bar = b.bar;
        __builtin_amdgcn_s_waitcnt(0);
        unsigned nloc = b.st[0], nx = b.st[1];
        if (nloc == 0u) { xcd_barrier_complete(bar, b.x, nloc, nx); b.st[0] = nloc; b.st[1] = nx; }
        const unsigned old = xb_add(&bar[XB_XSUB(b.x)], 1u);
        const unsigned gen = old / nloc;
        if (old + 1u == (gen + 1u) * nloc) {
            __builtin_amdgcn_fence(__ATOMIC_RELEASE, "agent");
            asm volatile("s_waitcnt vmcnt(0)" ::: "memory");
            const unsigned og = xb_add(&bar[XB_TOP], 1u);
            const unsigned tg = og / nx;
            if (og + 1u == (tg + 1u) * nx) xb_add(&bar[XB_TOPGEN], 1u);
            else XB_SPIN(xb_ld(&bar[XB_TOPGEN]) == tg, bar);
            __builtin_amdgcn_fence(__ATOMIC_ACQUIRE, "agent");
            xb_add(&bar[XB_XGEN(b.x)], 1u);
            asm volatile("s_waitcnt vmcnt(0)" ::: "memory");
        } else {
            XB_SPIN(xb_ld(&bar[XB_XGEN(b.x)]) == gen, bar);
            __builtin_amdgcn_fence(__ATOMIC_ACQUIRE, "agent");
            asm volatile("s_waitcnt vmcnt(0)" ::: "memory");
        }
    }
    __syncthreads();
}

__global__ void __launch_bounds__(512, 2) hymba_fwd(Args a) {
    extern __shared__ __attribute__((aligned(16))) unsigned char lds_raw[];
    LAS unsigned char* lds = (LAS unsigned char*)lds_raw;
    cg::grid_group grid = cg::this_grid();
    if (threadIdx.x < 16) ((volatile LAS unsigned*)(lds + LDS_BYTES - 64))[threadIdx.x] = 0u;
    __syncthreads();
    const XcdBarrier xbar = xcd_barrier_post((unsigned*)(a.ws + WS_BAR), (volatile LAS unsigned*)(lds + LDS_BYTES - 64));
    const int tid = threadIdx.x, lane = tid & 63, wave = __builtin_amdgcn_readfirstlane(tid >> 6);
    const int G = gridDim.x, bid = blockIdx.x;
    unsigned char* ws = a.ws;
    const float *xp = a.in[0], *xs = a.in[1], *cache_k = a.in[2], *cache_v = a.in[3], *state_in = a.in[4], *norm_attn = a.in[5], *w_in = a.in[6], *lbw = a.in[7],
                *hgn = a.in[8], *lq1 = a.in[9], *lk1 = a.in[10], *lq2 = a.in[11], *lk2 = a.in[12], *subln = a.in[13], *w_out = a.in[14], *norm_mlp = a.in[15],
                *w_up = a.in[16], *w_down = a.in[17], *norm_final = a.in[18];
    float* out = a.out;
    float *SS2 = (float*)(ws + WS_SS2), *DD = (float*)(ws + WS_DD), *LOGF = (float*)(ws + WS_LOGF), *UT = (float*)(ws + WS_UT), *X2 = (float*)(ws + WS_X2);
    bf16 *WoutT = (bf16*)(ws + WS_WOUT), *WupT = (bf16*)(ws + WS_WUP), *WdownT = (bf16*)(ws + WS_WDOWN), *WinT = (bf16*)(ws + WS_WIN), *XN = (bf16*)(ws + WS_XN),
         *STB = (bf16*)(ws + WS_STB), *X2B = (bf16*)(ws + WS_X2B), *QG = (bf16*)(ws + WS_QG), *VI = (bf16*)(ws + WS_VI), *GG = (bf16*)(ws + WS_GG), *MIX = (bf16*)(ws + WS_MIX),
         *QB = (bf16*)(ws + WS_QB), *KB = (bf16*)(ws + WS_KB), *VB = (bf16*)(ws + WS_VB), *U = (bf16*)(ws + WS_U);
    float* AP = (float*)(ws + WS_AP);

    REP(0) {
        LAS float* scr = (LAS float*)(lds + wave * 16384);
        const int gw = bid * 8 + wave, NGW = G * 8;
        constexpr int I_IN = (DM / 64) * (INW / 32), I_OUT = (DM / 64) * (DM / 32), I_UP = (DM / 64) * (FF / 32), I_DN = (FF / 64) * (DM / 32);
        for (int it = gw; it < I_IN + I_OUT + I_UP + I_DN; it += NGW) {
            int r = it;
            if (r < I_IN) { p0_transpose_item(w_in, DM, INW, WinT, nullptr, scr, r, lane); continue; } r -= I_IN;
            if (r < I_OUT) { p0_transpose_item(w_out, DM, DM, WoutT, nullptr, scr, r, lane); continue; } r -= I_OUT;
            if (r < I_UP) { p0_transpose_item(w_up, DM, FF, WupT, norm_mlp, scr, r, lane); continue; } r -= I_UP;
            p0_transpose_item(w_down, FF, DM, WdownT, nullptr, scr, r, lane);
        }
        for (int m = gw; m < MT; m += NGW) {
            const f32x4* xr = (const f32x4*)(m < MP ? xp + (size_t)m * DM : xs + (size_t)(m - MP) * DM) + lane;
            f32x4 v[8]; float s = 0.f;
#pragma unroll
            for (int j = 0; j < 8; ++j) { v[j] = xr[64 * j]; s += (v[j][0] * v[j][0] + v[j][1] * v[j][1]) + (v[j][2] * v[j][2] + v[j][3] * v[j][3]); }
            const float rstd = __builtin_amdgcn_rsqf(wave_sum(s) * (1.f / DM) + EPS);
            u32x2* o8 = (u32x2*)(XN + (size_t)m * DM) + lane;
#pragma unroll
            for (int j = 0; j < 8; ++j) { const f32x4 g = ((const f32x4*)norm_attn)[lane + 64 * j]; u32x2 w;
                w.x = pk2(v[j][0] * rstd * g[0], v[j][1] * rstd * g[1]); w.y = pk2(v[j][2] * rstd * g[2], v[j][3] * rstd * g[3]); o8[64 * j] = w; }
        }
        for (int i = bid * 512 + tid; i < MT; i += G * 512) { SS2[i] = 0.f; }
    }
    grid.sync();

    REP(1) {
        pg8::Gemm g{XN, WinT, MT, INW, DM}; pg8::StaticOrder S; S.init(MT, INW, G, bid, DM / 64);
        Epi1 E{QG, VI, GG, QB, KB, VB, LOGF, out, lbw};
        pg8::gemm_phase<Epi1, pg8::StaticOrder, true, true>(lds, g, S, E);
    }
    xcd_barrier(xbar);

    {
        REP(2) for (int it = bid; it < NCH * NH; it += G) gla1_item(lds, it >> 3, it & 7, VI, LOGF, UT, DD, STB, state_in, out + O_SS, tid, wave, lane);
        const float sa = wave_sum(lq1[lane] * lk1[lane]), sb = wave_sum(lq2[lane] * lk2[lane]);
        const float lam = __expf(sa) - __expf(sb) + LAM_INIT;
        REP(3) { for (int pp = bid; pp < 256; pp += G) {
            const int h = pp >> 5, i = pp & 31, spos = pp % 3;
#pragma unroll 1
            for (int e = 0; e < 3; ++e) {
                int tid2 = tid; asm volatile("" : "+v"(tid2));
                const int lane2 = tid2 & 63;
                if (e == spos) {
                    const int su = pp >> 2, sq = pp & 3, b = su >> 3, hs = su & 7;
                    attn_unit_s(lds, QB + (size_t)(MP + b * 64) * HW + hs * 128, cache_k + ((size_t)b * PAST * NH + hs) * 128, cache_v + ((size_t)b * PAST * NH + hs) * 128,
                                16 * sq, 16, sq == 3, out + O_KS + (size_t)(b * 64) * HW + hs * 128, out + O_VS + (size_t)(b * 64) * HW + hs * 128,
                                AP + (size_t)pp * 2 * AP_MAP, tid2, wave, lane2);
                }
                if (e < 2) { const int qb = e ? 63 - i : i;
                    attn_unit(lds, QB + (size_t)(qb * 128) * HW + h * 128, KB + h * 128, VB + h * 128, 2 * (qb + 1),
                              MIX + (size_t)(qb * 128) * DM + HW + h * 128, lam, subln, tid2, wave, lane2); }
            }
        } }
    }
    xcd_barrier(xbar);

    REP(4) for (int gid = bid * 512 + tid; gid < NH * 16384; gid += G * 512) {
        const int h = gid >> 14, e = gid & 16383, k = e & 127, dv = e >> 7;
        float run = 0.f;
        for (int c0 = 0; c0 < NCH_P; c0 += 8) {
            float u[8], dd[8];
#pragma unroll
            for (int j = 0; j < 8; ++j) { u[j] = UT[(size_t)((c0 + j) * NH + h) * 16384 + e]; dd[j] = DD[((c0 + j) * NH + h) * 128 + k]; }
#pragma unroll
            for (int j = 0; j < 8; ++j) { STB[(size_t)((c0 + j) * NH + h) * 16384 + e] = (bf16)(pk2(run, 0.f) & 0xffffu); run = dd[j] * run + u[j]; }
        }
        out[O_SP + (size_t)(h * 128 + k) * 128 + dv] = run;
    }
    xcd_barrier(xbar);

    REP(5) for (int it = bid; it < NCH * NH; it += G) gla3_item(lds, it >> 3, it & 7, QG, VI, GG, LOGF, STB, hgn, MIX, tid, wave, lane);
    {
        const float sa = wave_sum(lq1[lane] * lk1[lane]), sb = wave_sum(lq2[lane] * lk2[lane]);
        const float lam = __expf(sa) - __expf(sb) + LAM_INIT;
        for (int rw = bid * 8 + wave; rw < 64 * 64; rw += G * 8) {
            const int su = rw >> 6, row = rw & 63, b = su >> 3, hs = su & 7;
            float oc[2][2];
#pragma unroll
            for (int c = 0; c < 2; ++c) {
                const float* p0 = AP + ((size_t)(su * 4) * 2 + c) * AP_MAP + (size_t)row * AP_ROW;
                float m[4], l[4]; float M = -3.0e38f;
#pragma unroll
                for (int q = 0; q < 4; ++q) { m[q] = p0[(size_t)q * 2 * AP_MAP + 128]; l[q] = p0[(size_t)q * 2 * AP_MAP + 129]; M = fmaxf(M, m[q]); }
                float L = 0.f, a0 = 0.f, a1 = 0.f;
#pragma unroll
                for (int q = 0; q < 4; ++q) { const float w = __builtin_amdgcn_exp2f(m[q] - M); L += w * l[q];
                    const float2 v = *(const float2*)(p0 + (size_t)q * 2 * AP_MAP + 2 * lane); a0 += w * v.x; a1 += w * v.y; }
                const float inv = 1.f / L; oc[c][0] = a0 * inv; oc[c][1] = a1 * inv;
            }
            const float v0 = oc[0][0] - lam * oc[1][0], v1 = oc[0][1] - lam * oc[1][1];
            const float ssq = wave_sum(v0 * v0 + v1 * v1);
            const float rms = __builtin_amdgcn_rsqf(ssq * (1.f / 128.f) + EPS) * (1.f - LAM_INIT);
            *(unsigned*)(MIX + (size_t)(MP + b * 64 + row) * DM + HW + hs * 128 + 2 * lane) = pk2(v0 * rms * subln[2 * lane], v1 * rms * subln[2 * lane + 1]);
        }
    }
    xcd_barrier(xbar);

    float* PART = (float*)(ws + WS_PART);
    {
        pg8::Gemm g{MIX, WoutT, MT, DM, DM}; SplitOrder S; S.init(MP, DM, G, bid, DM / 64, 16);
        Epi2 E{xp, xs, X2, X2B, SS2, PART};
        pg8::gemm_phase<Epi2, SplitOrder, true, true>(lds, g, S, E);
    }
    xcd_barrier(xbar);
    for (int r = wave * G + bid; r < MS; r += 8 * G) {
        const size_t m = (size_t)MP + r; float ss = 0.f;
#pragma unroll
        for (int j = 0; j < 8; ++j) { const int cix = (lane + 64 * j) * 4; f32x4 v = *(const f32x4*)(xs + (size_t)r * DM + cix);
#pragma unroll
            for (int p = 0; p < 16; ++p) v = v + *(const f32x4*)(PART + ((size_t)p * MS + r) * DM + cix);
            ss += (v[0] * v[0] + v[1] * v[1]) + (v[2] * v[2] + v[3] * v[3]);
            *(f32x4*)(X2 + m * DM + cix) = v; u32x2 w; w.x = pk2(v[0], v[1]); w.y = pk2(v[2], v[3]); *(u32x2*)(X2B + m * DM + cix) = w; }
        ss = wave_sum(ss);
        if (lane == 0) SS2[m] = ss;
    }
    xcd_barrier(xbar);

    REP(6) {
        pg8::Gemm g{X2B, WupT, MT, FF, DM}; SplitOrder S; S.init(MP, FF, G, bid, DM / 64, 4);
        Epi3 E{U, SS2, PART};
        pg8::gemm_phase<Epi3, SplitOrder, true, true>(lds, g, S, E);
    }
    xcd_barrier(xbar);
    for (int r = wave * G + bid; r < MS; r += 8 * G) {
        const size_t m = (size_t)MP + r;
        const float rstd = __builtin_amdgcn_rsqf(SS2[m] * (1.f / DM) + EPS);
#pragma unroll 4
        for (int j = 0; j < 32; ++j) { const int cix = (lane + 64 * j) * 4; f32x4 v = *(const f32x4*)(PART + (size_t)r * FF + cix);
#pragma unroll
            for (int p = 1; p < 4; ++p) v = v + *(const f32x4*)(PART + ((size_t)p * MS + r) * FF + cix);
#pragma unroll
            for (int q = 0; q < 4; ++q) { const float t = fmaxf(v[q] * rstd, 0.f); v[q] = t * t; }
            u32x2 w; w.x = pk2(v[0], v[1]); w.y = pk2(v[2], v[3]); *(u32x2*)(U + m * FF + cix) = w; }
    }
    xcd_barrier(xbar);

    {
        pg8::Gemm g{U, WdownT, MT, DM, FF}; SplitOrder S; S.init(MP, DM, G, bid, FF / 64, 16);
        Epi4 E{X2, out + O_Y, PART};
        pg8::gemm_phase<Epi4, SplitOrder, true, true>(lds, g, S, E);
    }
    xcd_barrier(xbar);

    {
        const int gw = bid * 8 + wave, NGW = G * 8;
        for (int m = gw; m < MT; m += NGW) {
            f32x4* yr = (f32x4*)(out + O_Y + (size_t)m * DM) + lane;
            f32x4 v[8]; float ss = 0.f;
            if (m < MP) {
#pragma unroll
                for (int j = 0; j < 8; ++j) v[j] = yr[64 * j];
            } else {
                const int r = m - MP;
#pragma unroll
                for (int j = 0; j < 8; ++j) { const int cix = (lane + 64 * j) * 4; v[j] = *(const f32x4*)(X2 + (size_t)m * DM + cix);
#pragma unroll
                    for (int p = 0; p < 16; ++p) v[j] = v[j] + *(const f32x4*)(PART + ((size_t)p * MS + r) * DM + cix); }
            }
#pragma unroll
            for (int j = 0; j < 8; ++j) ss += (v[j][0] * v[j][0] + v[j][1] * v[j][1]) + (v[j][2] * v[j][2] + v[j][3] * v[j][3]);
            const float rstd = __builtin_amdgcn_rsqf(wave_sum(ss) * (1.f / DM) + EPS);
#pragma unroll
            for (int j = 0; j < 8; ++j) { const f32x4 g = ((const f32x4*)norm_final)[lane + 64 * j]; yr[64 * j] = v[j] * rstd * g; }
        }
    }
}

extern "C" void kernel_launch(void* const* d_in, const int* in_sizes, int n_in, void* d_out, int out_size, void* d_ws, size_t ws_size, hipStream_t stream) {
    static int grid = 0;
    if (grid == 0) {
        if (n_in != 19 || ws_size < WS_END) { fprintf(stderr, "kernel_launch: expected 19 inputs and >= %zu bytes of workspace; got %d, %zu\n", (size_t)WS_END, n_in, ws_size); grid = -1; return; }
        int dev = 0, cus = 0, per_cu = 0;
        hipGetDevice(&dev);
        hipDeviceGetAttribute(&cus, hipDeviceAttributeMultiprocessorCount, dev);
        if (hipFuncSetAttribute((const void*)hymba_fwd, hipFuncAttributeMaxDynamicSharedMemorySize, LDS_BYTES) != hipSuccess) { fprintf(stderr, "kernel_launch: hipFuncSetAttribute failed\n"); grid = -1; return; }
        if (hipOccupancyMaxActiveBlocksPerMultiprocessor(&per_cu, (const void*)hymba_fwd, 512, LDS_BYTES) != hipSuccess || per_cu < 1) { fprintf(stderr, "kernel_launch: occupancy query failed (%d)\n", per_cu); grid = -1; return; }
        grid = cus * (per_cu > 1 ? 1 : per_cu);
    }
    if (grid < 0) return;
    if (hipMemsetAsync((char*)d_ws + WS_BAR, 0, WS_BAR_BYTES, stream) != hipSuccess) { fprintf(stderr, "kernel_launch: memset failed\n"); return; }
    Args a{};
    for (int i = 0; i < 19; ++i) a.in[i] = (const float*)d_in[i];
    a.out = (float*)d_out; a.ws = (unsigned char*)d_ws;
    void* args[] = {&a};
    hipError_t e = hipLaunchCooperativeKernel((const void*)hymba_fwd, dim3(grid), dim3(512), args, LDS_BYTES, stream);
    if (e != hipSuccess) fprintf(stderr, "cooperative launch failed: %s (grid %d)\n", hipGetErrorString(e), grid);
}
```

```cpp
#include <hip/hip_runtime.h>
#include <hip/hip_cooperative_groups.h>
#include <cstdio>
#include <cstdint>
namespace cg = cooperative_groups;
namespace pg8 {
#define PG8_LAS __attribute__((address_space(3)))
typedef unsigned short bf16_t;
typedef short bf16x8 __attribute__((ext_vector_type(8)));
typedef float f32x4 __attribute__((ext_vector_type(4)));
typedef unsigned u32x4 __attribute__((ext_vector_type(4)));
constexpr int BM = 256, BK = 64, HALF = 128, HTB = HALF * BK * 2  , STAGE_BYTES = 8 * HTB, NXCD = 8, WGM = 8;

__host__ __device__ __forceinline__ int lds_byte(int r, int c) { const int st = (r >> 4) * 2 + (c >> 5), rr = r & 15, cc = c & 31, ob = rr * 64 + cc * 2; return st * 1024 + (ob ^ (((ob >> 9) & 1) << 5)); }
__host__ __device__ __forceinline__ void stage_rc(int b, int& R, int& C) { const int st = b / 1024, sb = b % 1024, swz = sb ^ (((sb >> 9) & 1) << 5); R = (st >> 1) * 16 + swz / 64; C = (st & 1) * 32 + (swz % 64) / 2; }
__host__ __device__ __forceinline__ int perm32(int rho) { const int n = rho >> 4, i = rho & 15; return 8 * (i >> 2) + 4 * n + (i & 3); }

struct Unit { int pm, pn, k0, nt, kind; };
struct Gemm { const bf16_t* A; const bf16_t* Bt; int M, N, K; };

struct StaticOrder {
    int nM, nN, nwg, G, c, ntk;
    __host__ __device__ void init(int M, int N, int G_, int c_, int ntk_) { nM = M / BM; nN = N / BM; nwg = nM * nN; G = G_; c = c_; ntk = ntk_; }
    __host__ __device__ bool next(int i, Unit& u) const {
        const long L = (long)i * G + c; if (L >= nwg) return false;
        int wgid = (int)L; { const int q = nwg / NXCD, r = nwg % NXCD, xcd = wgid % NXCD, off = wgid / NXCD; wgid = (xcd < r ? xcd * (q + 1) : r * (q + 1) + (xcd - r) * q) + off; }
        const int nig = WGM * nN, gid = wgid / nig, fm = gid * WGM, gsz = (nM - fm) < WGM ? (nM - fm) : WGM;
        u.pm = fm + ((wgid % nig) % gsz); u.pn = (wgid % nig) / gsz; u.k0 = 0; u.nt = ntk; u.kind = 0; return true;
    }
    __device__ __forceinline__ void a_ready(const Unit&) const {}
    __device__ __forceinline__ void done(const Unit&) const {}
};

__device__ __forceinline__ unsigned cvt_pk_bf16(float lo, float hi) { unsigned r; asm volatile("v_cvt_pk_bf16_f32 %0, %1, %2" : "=v"(r) : "v"(lo), "v"(hi)); return r; }
typedef float f32x2 __attribute__((ext_vector_type(2)));
template <class Epi, class Sched, bool ALIGN_EPI = false, bool SP2 = false>
__device__ __forceinline__ void gemm_phase(PG8_LAS unsigned char* lds, const Gemm g, const Sched& S, const Epi& E) {
    const int tid = threadIdx.x, wid = __builtin_amdgcn_readfirstlane(tid >> 6), lane = tid & 63, wr = wid >> 2, wc = wid & 3, fr = lane & 15, fq = lane >> 4;
    const int K = g.K;
    unsigned voffA[2], voffB[2];
#pragma unroll
    for (int i = 0; i < 2; ++i) { int R, C; stage_rc(tid * 16 + i * 8192, R, C); const int Rb = Epi::PERM ? ((R & ~31) + perm32(R & 31)) : R;
        voffA[i] = (unsigned)(R * K + C) * 2u; voffB[i] = (unsigned)(Rb * K + C) * 2u; }
    const size_t kstep = (size_t)(BK * 2);
    const size_t hstep = (size_t)HALF * K * 2;
    const size_t tstep = 2 * hstep;
    const unsigned ldsw = (unsigned)wid * 1024u;
    const int aoff = lds_byte(wr * 64 + fr, fq * 8), boff = lds_byte(wc * 32 + fr, fq * 8);
#define PG8_SA(b, h) (((b) * 2 + (h)) * HTB)
#define PG8_SB(b, h) ((4 + (b) * 2 + (h)) * HTB)
#define PG8_STAGE(bufoff, gbase, voff) do { _Pragma("unroll") for (int _i = 0; _i < 2; ++_i) \
        __builtin_amdgcn_global_load_lds((const unsigned*)((const char*)(gbase) + (voff)[_i]), (PG8_LAS unsigned*)(lds + (bufoff) + ldsw + _i * 8192), 16, 0, 0); } while (0)
#define PG8_LDA(dst, b, h) do { _Pragma("unroll") for (int m = 0; m < 4; ++m) _Pragma("unroll") for (int k = 0; k < 2; ++k) dst[m][k] = *(const PG8_LAS bf16x8*)(lds + PG8_SA(b, h) + aoff + m * 2048 + k * 1024); } while (0)
#define PG8_LDB(dst, b, h) do { _Pragma("unroll") for (int n = 0; n < 2; ++n) _Pragma("unroll") for (int k = 0; k < 2; ++k) dst[n][k] = *(const PG8_LAS bf16x8*)(lds + PG8_SB(b, h) + boff + n * 2048 + k * 1024); } while (0)
#define PG8_MMA(ai, bj, At, Bt) do { __builtin_amdgcn_s_setprio(1); _Pragma("unroll") for (int m = 0; m < 4; ++m) _Pragma("unroll") for (int n = 0; n < 2; ++n) _Pragma("unroll") for (int k = 0; k < 2; ++k) \
        acc[ai][bj][m][n] = __builtin_amdgcn_mfma_f32_16x16x32_bf16(Bt[n][k], At[m][k], acc[ai][bj][m][n], 0, 0, 0); __builtin_amdgcn_s_setprio(0); } while (0)
#define PG8_WAIT_V(n) asm volatile("s_waitcnt vmcnt(" #n ")" ::: "memory")
#define PG8_WAIT_L(n) asm volatile("s_waitcnt lgkmcnt(" #n ")" ::: "memory")
#define PG8_BAR __builtin_amdgcn_s_barrier()
#define PG8_SCHED __builtin_amdgcn_sched_barrier(0)
    Unit cur, nxt; int ui = 0;
    if (!S.next(0, cur)) return;
    f32x4 acc[2][2][4][2];
#pragma unroll
    for (int a = 0; a < 2; ++a)
#pragma unroll
        for (int b = 0; b < 2; ++b)
#pragma unroll
            for (int m = 0; m < 4; ++m)
#pragma unroll
                for (int n = 0; n < 2; ++n) acc[a][b][m][n] = (f32x4){0.f, 0.f, 0.f, 0.f};
    bf16x8 At[4][2], B0[2][2], B1[2][2];
    const char* cA = (const char*)g.A + (size_t)cur.pm * tstep + (size_t)cur.k0 * kstep; const char* cB = (const char*)g.Bt + (size_t)cur.pn * tstep + (size_t)cur.k0 * kstep;
    S.a_ready(cur);
    if constexpr (SP2) {
        PG8_STAGE(PG8_SB(0, 0), cB, voffB); PG8_STAGE(PG8_SB(0, 1), cB + hstep, voffB); PG8_STAGE(PG8_SA(0, 0), cA, voffA); PG8_STAGE(PG8_SA(0, 1), cA + hstep, voffA);
        if (wr == 1) PG8_BAR;
        PG8_WAIT_V(2); PG8_BAR;
        PG8_STAGE(PG8_SB(1, 0), cB + kstep, voffB); PG8_STAGE(PG8_SA(1, 0), cA + kstep, voffA); PG8_STAGE(PG8_SB(1, 1), cB + hstep + kstep, voffB);
        PG8_WAIT_V(6); PG8_BAR;
    } else {
        PG8_STAGE(PG8_SB(0, 0), cB, voffB); PG8_STAGE(PG8_SA(0, 0), cA, voffA); PG8_STAGE(PG8_SB(0, 1), cB + hstep, voffB); PG8_STAGE(PG8_SA(0, 1), cA + hstep, voffA);
        if (wr == 1) PG8_BAR;
        PG8_WAIT_V(4); PG8_BAR;
        PG8_STAGE(PG8_SB(1, 0), cB + kstep, voffB); PG8_STAGE(PG8_SA(1, 0), cA + kstep, voffA); PG8_STAGE(PG8_SB(1, 1), cB + hstep + kstep, voffB);
        PG8_WAIT_V(6); PG8_BAR;
    }
    for (;;) {
        const bool has_next = S.next(ui + 1, nxt);
        const char* nA = has_next ? (const char*)g.A + (size_t)nxt.pm * tstep + (size_t)nxt.k0 * kstep : cA; const char* nB = has_next ? (const char*)g.Bt + (size_t)nxt.pn * tstep + (size_t)nxt.k0 * kstep : cB;
        const int nt = cur.nt;
        for (int t = 0; t < nt; t += 2) {
            const bool last = (t == nt - 2);
            const char* a1 = cA + (size_t)(t + 1) * kstep;
            const char* a2 = last ? nA : cA + (size_t)(t + 2) * kstep; const char* b2 = last ? nB : cB + (size_t)(t + 2) * kstep;
            const char* a3 = a2 + kstep; const char* b3 = b2 + kstep;
            if (last && has_next) S.a_ready(nxt);
            if constexpr (SP2) {
            PG8_LDB(B0, 0, 0); PG8_LDB(B1, 0, 1); PG8_SCHED; PG8_LDA(At, 0, 0); PG8_STAGE(PG8_SA(1, 1), a1 + hstep, voffA);
            PG8_WAIT_V(8); PG8_WAIT_L(0); PG8_BAR; PG8_MMA(0, 0, At, B0); PG8_MMA(0, 1, At, B1); PG8_BAR; PG8_SCHED;
            PG8_LDA(At, 0, 1); PG8_STAGE(PG8_SB(0, 0), b2, voffB); PG8_STAGE(PG8_SB(0, 1), b2 + hstep, voffB); PG8_STAGE(PG8_SA(0, 0), a2, voffA);
            PG8_WAIT_V(8); PG8_WAIT_L(0); PG8_BAR; PG8_MMA(1, 0, At, B0); PG8_MMA(1, 1, At, B1); PG8_BAR; PG8_SCHED;
            PG8_LDB(B0, 1, 0); PG8_LDB(B1, 1, 1); PG8_SCHED; PG8_LDA(At, 1, 0); PG8_STAGE(PG8_SA(0, 1), a2 + hstep, voffA);
            PG8_WAIT_V(8); PG8_WAIT_L(0); PG8_BAR; PG8_MMA(0, 0, At, B0); PG8_MMA(0, 1, At, B1); PG8_BAR; PG8_SCHED;
            PG8_LDA(At, 1, 1); PG8_STAGE(PG8_SB(1, 0), b3, voffB); PG8_STAGE(PG8_SB(1, 1), b3 + hstep, voffB); PG8_STAGE(PG8_SA(1, 0), a3, voffA);
            PG8_WAIT_V(8); PG8_WAIT_L(0); PG8_BAR; PG8_MMA(1, 0, At, B0); PG8_MMA(1, 1, At, B1); PG8_BAR; PG8_SCHED;
            } else {
            PG8_LDB(B0, 0, 0); PG8_SCHED; PG8_LDA(At, 0, 0); PG8_STAGE(PG8_SA(1, 1), a1 + hstep, voffA);
            PG8_WAIT_L(8); PG8_BAR; PG8_WAIT_L(0); PG8_MMA(0, 0, At, B0); PG8_BAR; PG8_SCHED;
            PG8_LDB(B1, 0, 1); PG8_STAGE(PG8_SB(0, 0), b2, voffB);
            PG8_BAR; PG8_WAIT_L(0); PG8_MMA(0, 1, At, B1); PG8_BAR;
            PG8_LDA(At, 0, 1); PG8_STAGE(PG8_SA(0, 0), a2, voffA);
            PG8_BAR; PG8_WAIT_L(0); PG8_MMA(1, 0, At, B0); PG8_BAR; PG8_SCHED;
            PG8_STAGE(PG8_SB(0, 1), b2 + hstep, voffB);
            PG8_WAIT_V(6); PG8_BAR; PG8_MMA(1, 1, At, B1); PG8_BAR;
            PG8_LDB(B0, 1, 0); PG8_SCHED; PG8_LDA(At, 1, 0); PG8_STAGE(PG8_SA(0, 1), a2 + hstep, voffA);
            PG8_WAIT_L(8); PG8_BAR; PG8_WAIT_L(0); PG8_MMA(0, 0, At, B0); PG8_BAR; PG8_SCHED;
            PG8_LDB(B1, 1, 1); PG8_STAGE(PG8_SB(1, 0), b3, voffB);
            PG8_BAR; PG8_WAIT_L(0); PG8_MMA(0, 1, At, B1); PG8_BAR;
            PG8_LDA(At, 1, 1); PG8_STAGE(PG8_SA(1, 0), a3, voffA);
            PG8_BAR; PG8_WAIT_L(0); PG8_MMA(1, 0, At, B0); PG8_BAR; PG8_SCHED;
            PG8_STAGE(PG8_SB(1, 1), b3 + hstep, voffB);
            PG8_WAIT_V(6); PG8_BAR; PG8_MMA(1, 1, At, B1); PG8_BAR;
            }
        }
        if constexpr (ALIGN_EPI) { if (wr == 0) PG8_BAR; }
        if constexpr (!Epi::AFTER_DRAIN) { E(acc, cur, wr, wc, fr, fq); S.done(cur); }
        if (!has_next) break;
#pragma unroll
        for (int a = 0; a < 2; ++a)
#pragma unroll
            for (int b = 0; b < 2; ++b)
#pragma unroll
                for (int m = 0; m < 4; ++m)
#pragma unroll
                    for (int n = 0; n < 2; ++n) acc[a][b][m][n] = (f32x4){0.f, 0.f, 0.f, 0.f};
        cur = nxt; cA = nA; cB = nB; ++ui;
        if constexpr (ALIGN_EPI) { if (wr == 1) PG8_BAR; }
    }
    PG8_WAIT_V(0);
    if constexpr (!ALIGN_EPI) { if (wr == 0) PG8_BAR; }
    PG8_BAR;
    if constexpr (Epi::AFTER_DRAIN) { E.fused(acc, cur, wr, wc, fr, fq, lds, wid, lane); S.done(cur); }
#undef PG8_SA
#undef PG8_SB
#undef PG8_STAGE
#undef PG8_LDA
#undef PG8_LDB
#undef PG8_MMA
#undef PG8_WAIT_V
#undef PG8_WAIT_L
#undef PG8_BAR
#undef PG8_SCHED
}
}

#define LAS __attribute__((address_space(3)))
typedef unsigned short bf16;
typedef short bf16x8 __attribute__((ext_vector_type(8)));
typedef short s16x4 __attribute__((ext_vector_type(4)));
typedef float f32x4 __attribute__((ext_vector_type(4)));
typedef float f32x16 __attribute__((ext_vector_type(16)));
typedef unsigned u32x4 __attribute__((ext_vector_type(4)));
typedef unsigned u32x2 __attribute__((ext_vector_type(2)));

constexpr int DM = 2048, MP = 8192, MS = 512, MT = MP + MS, INW = 7168, FF = 8192, HW = 1024;
constexpr int NH = 8, NCH_P = 128, NCH = 136, PAST = 4096, KVS = PAST + 64;
constexpr float EPS = 1e-6f;
constexpr float QSCALE = 0.125f * 1.44269504088896340736f;
constexpr float LAM_INIT = 0.2f;

constexpr size_t O_Y = 0, O_KP = (size_t)MT * DM, O_VP = O_KP + (size_t)MP * HW, O_SP = O_VP + (size_t)MP * HW,
                 O_KS = O_SP + (size_t)NH * 128 * 128, O_VS = O_KS + (size_t)MS * HW, O_SS = O_VS + (size_t)MS * HW;
constexpr size_t MiB = 1u << 20;
constexpr size_t WS_SS2 = 0, WS_SS3 = 64 * 1024, WS_BAR = 128 * 1024, WS_BAR_BYTES = 16384, WS_DD = 512 * 1024;
constexpr size_t WS_WOUT = 1 * MiB, WS_WUP = 9 * MiB, WS_WDOWN = 41 * MiB, WS_WIN = 73 * MiB, WS_XN = 101 * MiB;
constexpr size_t WS_STB = 73 * MiB, WS_X2B = 73 * MiB;
constexpr size_t WS_PART = 135 * MiB;
constexpr size_t WS_QG = 135 * MiB, WS_VI = 152 * MiB, WS_GG = 169 * MiB, WS_LOGF = 186 * MiB, WS_MIX = 220 * MiB;
constexpr size_t WS_UT = 254 * MiB, WS_X2 = 254 * MiB, WS_QB = 322 * MiB, WS_KB = 339 * MiB, WS_VB = 356 * MiB;
constexpr size_t WS_AP = 107 * MiB;
constexpr size_t WS_U = 339 * MiB, WS_END = 475 * MiB;
static_assert(WS_U + (size_t)MT * FF * 2 <= WS_END && WS_X2 + (size_t)MT * DM * 4 <= WS_QB && WS_VB + (size_t)MT * HW * 2 <= WS_END, "ws map");

constexpr int LDS_BYTES = 147456;
#ifndef PROBE_MASK
#define PROBE_MASK 0
#endif
#define REP(k) for (int rep_ = 0; rep_ < ((PROBE_MASK >> (k)) & 1) + 1; ++rep_)

struct Args { const float* in[19]; float* out; unsigned char* ws; };

__device__ __forceinline__ float bf2f(unsigned short b) { return __uint_as_float((unsigned)b << 16); }
__device__ __forceinline__ unsigned pk2(float lo, float hi) { return pg8::cvt_pk_bf16(lo, hi); }
__device__ __forceinline__ float wave_sum(float v) {
#pragma unroll
    for (int o = 1; o < 64; o <<= 1) v += __shfl_xor(v, o);
    return v;
}
__device__ __forceinline__ float fexp(float x) { return __builtin_amdgcn_exp2f(x * 1.44269504088896340736f); }
__device__ __forceinline__ float sigm(float x) { return __builtin_amdgcn_rcpf(1.f + fexp(-x)); }
__device__ __forceinline__ int crow(int i, int hh) { return (i & 3) + 8 * (i >> 2) + 4 * hh; }
#define MFMA32(a, b, c) __builtin_amdgcn_mfma_f32_32x32x16_bf16((a), (b), (c), 0, 0, 0)
__device__ __forceinline__ bf16x8 pack8(const f32x16& x, int half) {
    u32x4 p;
    p.x = pk2(x[8 * half + 0], x[8 * half + 1]); p.y = pk2(x[8 * half + 2], x[8 * half + 3]);
    p.z = pk2(x[8 * half + 4], x[8 * half + 5]); p.w = pk2(x[8 * half + 6], x[8 * half + 7]);
    return __builtin_bit_cast(bf16x8, p);
}
__device__ __forceinline__ bf16x8 tr2(const LAS unsigned char* p0, const LAS unsigned char* p1) {
    const s16x4 a = __builtin_amdgcn_ds_read_tr16_b64_v4i16((LAS s16x4*)p0);
    const s16x4 b = __builtin_amdgcn_ds_read_tr16_b64_v4i16((LAS s16x4*)p1);
    return __builtin_shufflevector(a, b, 0, 1, 2, 3, 4, 5, 6, 7);
}


struct SplitOrder {
    pg8::StaticOrder base; int nb, c, G, s_nN, s_splits, s_nt, s_units;
    __device__ void init(int Mp, int N, int G_, int c_, int ntk, int splits) {
        base.init(Mp, N, G_, c_, ntk); G = G_; c = c_;
        nb = c_ < base.nwg ? (base.nwg - c_ + G_ - 1) / G_ : 0;
        s_nN = N / 256; s_splits = splits; s_nt = ntk / splits; s_units = 2 * s_nN * splits;
    }
    __device__ bool next(int i, pg8::Unit& u) const {
        if (i < nb) return base.next(i, u);
        const int L = (i - nb) * G + c; if (L >= s_units) return false;
        const int tile = L / s_splits, j = L % s_splits;
        u.pm = 32 + tile / s_nN; u.pn = tile % s_nN; u.k0 = j * s_nt; u.nt = s_nt; u.kind = 1 + j; return true;
    }
    __device__ __forceinline__ void a_ready(const pg8::Unit&) const {}
    __device__ __forceinline__ void done(const pg8::Unit&) const {}
};
__device__ __forceinline__ void store_partial(const pg8::f32x4 (&acc)[2][2][4][2], const pg8::Unit& u, int wr, int wc, int fr, int fq, float* PART, int N) {
    const int cbase = u.pn * 256 + wc * 32 + fq * 4, rbase = (u.pm - 32) * 256 + wr * 64 + fr;
    float* P = PART + (size_t)(u.kind - 1) * 512 * N;
#pragma unroll
    for (int ai = 0; ai < 2; ++ai)
#pragma unroll
        for (int m = 0; m < 4; ++m)
#pragma unroll
            for (int bj = 0; bj < 2; ++bj)
#pragma unroll
                for (int n = 0; n < 2; ++n) *(pg8::f32x4*)(P + (size_t)(rbase + ai * 128 + m * 16) * N + cbase + bj * 128 + n * 16) = acc[ai][bj][m][n];
}

struct Epi1 {
    static constexpr bool PERM = false, AFTER_DRAIN = false;
    bf16 *QG, *VI, *GG, *QB, *KB, *VB; float* LOGF; float* out; const float* lbw;
    __device__ __forceinline__ void operator()(const f32x4 (&acc)[2][2][4][2], const pg8::Unit& u, int wr, int wc, int fr, int fq) const {
        const int region = u.pn >> 2;
        const int cbase = (u.pn & 3) * 256 + wc * 32 + fq * 4;
        const int rbase = u.pm * 256 + wr * 64 + fr;
        if (region == 1) {
            f32x4 lb[2][2];
#pragma unroll
            for (int bj = 0; bj < 2; ++bj)
#pragma unroll
                for (int n = 0; n < 2; ++n) { const int c = cbase + bj * 128 + n * 16; const f32x4 l0 = *(const f32x4*)(lbw + c), l1 = *(const f32x4*)(lbw + HW + c);
#pragma unroll
                    for (int j = 0; j < 4; ++j) lb[bj][n][j] = 1.f / (1.f + __expf(l1[j] - l0[j])); }
#pragma unroll
            for (int ai = 0; ai < 2; ++ai)
#pragma unroll
                for (int m = 0; m < 4; ++m) { const size_t row = rbase + ai * 128 + m * 16;
#pragma unroll
                    for (int bj = 0; bj < 2; ++bj)
#pragma unroll
                        for (int n = 0; n < 2; ++n) { const f32x4 v = acc[ai][bj][m][n]; f32x4 o;
#pragma unroll
                            for (int j = 0; j < 4; ++j) { const float l = lb[bj][n][j]; o[j] = logf(l + (1.f - l) * sigm(v[j])); }
                            *(f32x4*)(LOGF + row * HW + cbase + bj * 128 + n * 16) = o; } }
        } else if (region <= 4) {
            bf16* dst = region == 0 ? QG : (region == 2 ? VI : (region == 3 ? GG : QB));
#pragma unroll
            for (int ai = 0; ai < 2; ++ai)
#pragma unroll
                for (int m = 0; m < 4; ++m) { const size_t row = rbase + ai * 128 + m * 16;
#pragma unroll
                    for (int bj = 0; bj < 2; ++bj)
#pragma unroll
                        for (int n = 0; n < 2; ++n) { f32x4 v = acc[ai][bj][m][n];
                            if (region == 0 || region == 3) {
#pragma unroll
                                for (int j = 0; j < 4; ++j) v[j] = v[j] * sigm(v[j]);
                            } else if (region == 4) v = v * QSCALE;
                            u32x2 w; w.x = pk2(v[0], v[1]); w.y = pk2(v[2], v[3]);
                            *(u32x2*)(dst + row * HW + cbase + bj * 128 + n * 16) = w; } }
        } else {
            const bool isk = region == 5; const bool prompt = u.pm < 32;
#pragma unroll
            for (int ai = 0; ai < 2; ++ai)
#pragma unroll
                for (int m = 0; m < 4; ++m) { const int row = rbase + ai * 128 + m * 16;
                    float* of;
                    bf16* ob = (isk ? KB : VB) + (size_t)row * HW;
                    if (prompt) of = out + (isk ? O_KP : O_VP) + (size_t)row * HW; else of = out + (isk ? O_KS : O_VS) + (size_t)(row - MP) * HW;
#pragma unroll
                    for (int bj = 0; bj < 2; ++bj)
#pragma unroll
                        for (int n = 0; n < 2; ++n) { const f32x4 v = acc[ai][bj][m][n]; const int c = cbase + bj * 128 + n * 16;
                            *(f32x4*)(of + c) = v; u32x2 w; w.x = pk2(v[0], v[1]); w.y = pk2(v[2], v[3]); *(u32x2*)(ob + c) = w; } }
        }
    }
};
struct Epi2 {
    static constexpr bool PERM = false, AFTER_DRAIN = false;
    const float *xp, *xs; float* X2; bf16* X2B; float* SS; float* PART;
    __device__ __forceinline__ void operator()(const f32x4 (&acc)[2][2][4][2], const pg8::Unit& u, int wr, int wc, int fr, int fq) const {
        if (u.kind) { store_partial(acc, u, wr, wc, fr, fq, PART, DM); return; }
        const int cbase = u.pn * 256 + wc * 32 + fq * 4, rbase = u.pm * 256 + wr * 64 + fr;
        const float* xin = u.pm < 32 ? xp : xs - (size_t)MP * DM;
#pragma unroll
        for (int ai = 0; ai < 2; ++ai)
#pragma unroll
            for (int m = 0; m < 4; ++m) { const size_t row = rbase + ai * 128 + m * 16; float ss = 0.f;
#pragma unroll
                for (int bj = 0; bj < 2; ++bj)
#pragma unroll
                    for (int n = 0; n < 2; ++n) { const size_t off = row * DM + cbase + bj * 128 + n * 16;
                        const f32x4 v = acc[ai][bj][m][n] + *(const f32x4*)(xin + off);
                        ss += (v[0] * v[0] + v[1] * v[1]) + (v[2] * v[2] + v[3] * v[3]);
                        *(f32x4*)(X2 + off) = v; u32x2 w; w.x = pk2(v[0], v[1]); w.y = pk2(v[2], v[3]); *(u32x2*)(X2B + off) = w; }
                ss += __shfl_xor(ss, 16); ss += __shfl_xor(ss, 32);
                if (fq == 0) atomicAdd(SS + row, ss); }
    }
};
struct Epi3 {
    static constexpr bool PERM = false, AFTER_DRAIN = false;
    bf16* U; const float* SS; float* PART;
    __device__ __forceinline__ void operator()(const f32x4 (&acc)[2][2][4][2], const pg8::Unit& u, int wr, int wc, int fr, int fq) const {
        if (u.kind) { store_partial(acc, u, wr, wc, fr, fq, PART, FF); return; }
        const int cbase = u.pn * 256 + wc * 32 + fq * 4, rbase = u.pm * 256 + wr * 64 + fr;
#pragma unroll
        for (int ai = 0; ai < 2; ++ai)
#pragma unroll
            for (int m = 0; m < 4; ++m) { const size_t row = rbase + ai * 128 + m * 16;
                const float rstd = __builtin_amdgcn_rsqf(__hip_atomic_load(SS + row, __ATOMIC_RELAXED, __HIP_MEMORY_SCOPE_AGENT) * (1.f / DM) + EPS);
#pragma unroll
                for (int bj = 0; bj < 2; ++bj)
#pragma unroll
                    for (int n = 0; n < 2; ++n) { f32x4 v = acc[ai][bj][m][n] * rstd;
#pragma unroll
                        for (int j = 0; j < 4; ++j) { const float t = fmaxf(v[j], 0.f); v[j] = t * t; }
                        u32x2 w; w.x = pk2(v[0], v[1]); w.y = pk2(v[2], v[3]); *(u32x2*)(U + row * FF + cbase + bj * 128 + n * 16) = w; } }
    }
};
struct Epi4 {
    static constexpr bool PERM = false, AFTER_DRAIN = false;
    const float* X2; float* Y; float* PART;
    __device__ __forceinline__ void operator()(const f32x4 (&acc)[2][2][4][2], const pg8::Unit& u, int wr, int wc, int fr, int fq) const {
        if (u.kind) { store_partial(acc, u, wr, wc, fr, fq, PART, DM); return; }
        const int cbase = u.pn * 256 + wc * 32 + fq * 4, rbase = u.pm * 256 + wr * 64 + fr;
#pragma unroll
        for (int ai = 0; ai < 2; ++ai)
#pragma unroll
            for (int m = 0; m < 4; ++m) { const size_t row = rbase + ai * 128 + m * 16;
#pragma unroll
                for (int bj = 0; bj < 2; ++bj)
#pragma unroll
                    for (int n = 0; n < 2; ++n) { const size_t off = row * DM + cbase + bj * 128 + n * 16;
                        *(f32x4*)(Y + off) = acc[ai][bj][m][n] + *(const f32x4*)(X2 + off); } }
    }
};

__device__ __forceinline__ void p0_transpose_item(const float* W, int K, int N, bf16* WT, const float* gain, LAS float* scr, int item, int lane) {
    const int nblk = N / 32, kb = item / nblk, nb = item % nblk, k0 = 64 * kb, n0 = 32 * nb;
    const int kk = lane >> 3, n4 = (lane & 7) * 4;
    f32x4 v[8];
#pragma unroll
    for (int j = 0; j < 8; ++j) v[j] = *(const f32x4*)(W + (size_t)(k0 + 8 * j + kk) * N + n0 + n4);
    if (gain) {
#pragma unroll
        for (int j = 0; j < 8; ++j) v[j] = v[j] * gain[k0 + 8 * j + kk];
    }
#pragma unroll
    for (int j = 0; j < 8; ++j) { LAS float* d = scr + (8 * j + kk) * 33 + n4; d[0] = v[j][0]; d[1] = v[j][1]; d[2] = v[j][2]; d[3] = v[j][3]; }
    asm volatile("s_waitcnt lgkmcnt(0)" ::: "memory");
    const int c = lane & 7;
#pragma unroll
    for (int j = 0; j < 4; ++j) { const int n = (lane >> 3) + 8 * j; const LAS float* sp = scr + (8 * c) * 33 + n;
        u32x4 o; o.x = pk2(sp[0 * 33], sp[1 * 33]); o.y = pk2(sp[2 * 33], sp[3 * 33]); o.z = pk2(sp[4 * 33], sp[5 * 33]); o.w = pk2(sp[6 * 33], sp[7 * 33]);
        *(u32x4*)(WT + (size_t)(n0 + n) * K + k0 + 8 * c) = o; }
    asm volatile("s_waitcnt lgkmcnt(0)" ::: "memory");
}

#define LBAR() do { asm volatile("s_waitcnt lgkmcnt(0)" ::: "memory"); __builtin_amdgcn_s_barrier(); asm volatile("" ::: "memory"); } while (0)
constexpr int A_KP = 272, A_VP = 320, A_KB = 64 * A_KP, A_VB = 64 * A_VP, A_STG = A_KB + A_VB, A_XOFF = 2 * A_STG, A_XP = 132;
static_assert(A_XOFF + 128 * A_XP * 4 <= LDS_BYTES - 64, "attention LDS");
__device__ __forceinline__ void attn_step(const LAS unsigned char* sb, int kaddr, int vaddr, const bf16x8 (&qf)[4], f32x16 (&o)[4], float& m_run, float& l_run, bool& rebased) {
#define A_VLOAD(V, ks) do { _Pragma("unroll") for (int dt = 0; dt < 4; ++dt) { const LAS unsigned char* va_ = sb + vaddr + (16 * (ks)) * A_VP + dt * 64; V[dt] = tr2(va_, va_ + 8 * A_VP); } } while (0)
#define A_PV(V, P) do { _Pragma("unroll") for (int dt = 0; dt < 4; ++dt) o[dt] = MFMA32(V[dt], P, o[dt]); } while (0)
#define A_SB() __builtin_amdgcn_sched_barrier(0)
    bf16x8 k0[4], k1[4];
#pragma unroll
    for (int s = 0; s < 4; ++s) { k0[s] = *(const LAS bf16x8*)(sb + kaddr + 32 * s); k1[s] = *(const LAS bf16x8*)(sb + kaddr + 32 * A_KP + 32 * s); }
    A_SB();
    f32x16 s0, s1;
#pragma unroll
    for (int i = 0; i < 16; ++i) { s0[i] = 0.f; s1[i] = 0.f; }
#pragma unroll
    for (int s = 0; s < 4; ++s) { s0 = MFMA32(k0[s], qf[s], s0); s1 = MFMA32(k1[s], qf[s], s1); }
    bf16x8 va[4], vb[4];
    A_VLOAD(va, 0);
    A_SB();
    float mx = __builtin_fmaxf(s0[0], s1[0]);
#pragma unroll
    for (int i = 1; i < 16; ++i) mx = __builtin_fmaxf(mx, __builtin_fmaxf(s0[i], s1[i]));
    mx = __builtin_fmaxf(mx, __shfl_xor(mx, 32));
    if (rebased) {
#pragma unroll
        for (int i = 0; i < 16; ++i) { s0[i] -= m_run; s1[i] -= m_run; }
        mx -= m_run;
    }
    const bool need = (mx > 32.f) || (mx < -64.f);
    if (__any(need)) {
        const float d = need ? mx : 0.f, alpha = __builtin_amdgcn_exp2f(-d);
        m_run += d; l_run *= alpha;
#pragma unroll
        for (int i = 0; i < 16; ++i) { s0[i] -= d; s1[i] -= d; }
#pragma unroll
        for (int dt = 0; dt < 4; ++dt) o[dt] = o[dt] * alpha;
        rebased = true;
    }
    float ls = 0.f;
#pragma unroll
    for (int i = 0; i < 16; ++i) { s0[i] = __builtin_amdgcn_exp2f(s0[i]); s1[i] = __builtin_amdgcn_exp2f(s1[i]); ls += s0[i] + s1[i]; }
    l_run += ls;
    bf16x8 pf[4]; pf[0] = pack8(s0, 0); pf[1] = pack8(s0, 1); pf[2] = pack8(s1, 0); pf[3] = pack8(s1, 1);
    A_SB();
    A_VLOAD(vb, 1); A_SB(); A_PV(va, pf[0]); A_SB();
    A_VLOAD(va, 2); A_SB(); A_PV(vb, pf[1]); A_SB();
    A_VLOAD(vb, 3); A_SB(); A_PV(va, pf[2]); A_SB();
    A_PV(vb, pf[3]);
#undef A_VLOAD
#undef A_PV
#undef A_SB
}

__device__ __forceinline__ void attn_unit(LAS unsigned char* lds, const bf16* qp, const bf16* kp, const bf16* vp, int ntiles,
                                          bf16* op, float lam, const float* subln, int tid, int wave, int lane) {
    const int c = wave >> 2, qt = wave & 3, r = lane & 31, hh = lane >> 5;
    const int myt = ntiles - (qt < 2 ? 1 : 0);
    bf16x8 qf[4];
    { const bf16* q = qp + (size_t)(qt * 32 + r) * HW + c * 64 + 8 * hh;
#pragma unroll
      for (int s = 0; s < 4; ++s) qf[s] = *(const bf16x8*)(q + 16 * s); }
    const int key0 = tid >> 4, ch = tid & 15;
    const size_t g0 = (size_t)key0 * HW + ch * 8, g1 = g0 + (size_t)32 * HW;
    const int lk0 = key0 * A_KP + ch * 16, lk1 = lk0 + 32 * A_KP, lv0 = A_KB + key0 * A_VP + ch * 16, lv1 = lv0 + 32 * A_VP;
    u32x4 sa0, sa1, sa2, sa3, sb0, sb1, sb2, sb3;
#define A_GLOAD(S, t) do { const size_t tb = (size_t)(t) * 64 * HW; S##0 = *(const u32x4*)(kp + tb + g0); S##1 = *(const u32x4*)(kp + tb + g1); S##2 = *(const u32x4*)(vp + tb + g0); S##3 = *(const u32x4*)(vp + tb + g1); } while (0)
#define A_LSTORE(S, b) do { LAS unsigned char* sb_ = lds + (b) * A_STG; *(LAS u32x4*)(sb_ + lk0) = S##0; *(LAS u32x4*)(sb_ + lk1) = S##1; *(LAS u32x4*)(sb_ + lv0) = S##2; *(LAS u32x4*)(sb_ + lv1) = S##3; } while (0)
    f32x16 o[4];
#pragma unroll
    for (int dt = 0; dt < 4; ++dt)
#pragma unroll
        for (int i = 0; i < 16; ++i) o[dt][i] = 0.f;
    float m_run = 0.f, l_run = 0.f; bool rebased = false;
    const int kaddr = r * A_KP + c * 128 + 16 * hh;
    const int g16 = (lane >> 4) & 1, i16 = lane & 15, tq = i16 >> 2, tp = i16 & 3;
    const int vaddr = A_KB + (4 * hh + tq) * A_VP + (g16 * 16 + 4 * tp) * 2;
    A_GLOAD(sa, 0); A_GLOAD(sb, 1); A_LSTORE(sa, 0); LBAR();
    for (int t = 0; t < ntiles; t += 2) {
        if (t + 2 < ntiles) A_GLOAD(sa, t + 2);
        if (t < myt) attn_step(lds, kaddr, vaddr, qf, o, m_run, l_run, rebased);
        A_LSTORE(sb, 1);
        LBAR();
        if (t + 3 < ntiles) A_GLOAD(sb, t + 3);
        if (t + 1 < myt) attn_step(lds + A_STG, kaddr, vaddr, qf, o, m_run, l_run, rebased);
        if (t + 2 < ntiles) A_LSTORE(sa, 0);
        LBAR();
    }
#undef A_GLOAD
#undef A_LSTORE
    const float lt = l_run + __shfl_xor(l_run, 32);
    const float inv = 1.f / lt;
    LAS float* X = (LAS float*)(lds + A_XOFF);
    if (c == 1) {
#pragma unroll
        for (int dt = 0; dt < 4; ++dt)
#pragma unroll
            for (int g = 0; g < 4; ++g) { f32x4 v; v[0] = o[dt][4 * g] * inv; v[1] = o[dt][4 * g + 1] * inv; v[2] = o[dt][4 * g + 2] * inv; v[3] = o[dt][4 * g + 3] * inv;
                *(LAS f32x4*)(X + (qt * 32 + r) * A_XP + dt * 32 + 8 * g + 4 * hh) = v; }
    }
    LBAR();
    if (c == 0) {
        float ssq = 0.f;
#pragma unroll
        for (int dt = 0; dt < 4; ++dt)
#pragma unroll
            for (int g = 0; g < 4; ++g) { const f32x4 x2 = *(const LAS f32x4*)(X + (qt * 32 + r) * A_XP + dt * 32 + 8 * g + 4 * hh);
#pragma unroll
                for (int j = 0; j < 4; ++j) { const float v = o[dt][4 * g + j] * inv - lam * x2[j]; o[dt][4 * g + j] = v; ssq += v * v; } }
        ssq += __shfl_xor(ssq, 32);
        const float rms = __builtin_amdgcn_rsqf(ssq * (1.f / 128.f) + EPS) * (1.f - LAM_INIT);
        bf16* orow = op + (size_t)(qt * 32 + r) * DM;
#pragma unroll
        for (int dt = 0; dt < 4; ++dt)
#pragma unroll
            for (int g = 0; g < 4; ++g) { const int dv = dt * 32 + 8 * g + 4 * hh; const f32x4 w = *(const f32x4*)(subln + dv);
                u32x2 pw; pw.x = pk2(o[dt][4 * g] * rms * w[0], o[dt][4 * g + 1] * rms * w[1]); pw.y = pk2(o[dt][4 * g + 2] * rms * w[2], o[dt][4 * g + 3] * rms * w[3]);
                *(u32x2*)(orow + dv) = pw; }
    }
}

constexpr int AP_ROW = 132, AP_MAP = 64 * AP_ROW;
__device__ __forceinline__ void attn_unit_s(LAS unsigned char* lds, const bf16* qp, const float* ck, const float* cv, int t0, int nc, bool has_new, const float* kn, const float* vn,
                                            float* ap, int tid, int wave, int lane) {
    const int c = wave >> 2, qt = wave & 3, r = lane & 31, hh = lane >> 5;
    const int ntiles = nc + (has_new ? 1 : 0);
    if (qt < 2) {
        bf16x8 qf[4];
        { const bf16* q = qp + (size_t)(qt * 32 + r) * HW + c * 64 + 8 * hh;
#pragma unroll
          for (int s = 0; s < 4; ++s) qf[s] = *(const bf16x8*)(q + 16 * s); }
        f32x16 o[4];
#pragma unroll
        for (int dt = 0; dt < 4; ++dt)
#pragma unroll
            for (int i = 0; i < 16; ++i) o[dt][i] = 0.f;
        float m_run = 0.f, l_run = 0.f; bool rebased = false;
        const int kaddr = r * A_KP + c * 128 + 16 * hh;
        const int g16 = (lane >> 4) & 1, i16 = lane & 15, tq = i16 >> 2, tp = i16 & 3;
        const int vaddr = A_KB + (4 * hh + tq) * A_VP + (g16 * 16 + 4 * tp) * 2;
        LBAR();
        for (int t = 0; t < ntiles; ++t) {
            attn_step(lds + (t & 1) * A_STG, kaddr, vaddr, qf, o, m_run, l_run, rebased);
            LBAR();
        }
        const float lt = l_run + __shfl_xor(l_run, 32);
        float* row = ap + (size_t)c * AP_MAP + (size_t)(qt * 32 + r) * AP_ROW;
#pragma unroll
        for (int dt = 0; dt < 4; ++dt)
#pragma unroll
            for (int g = 0; g < 4; ++g) { f32x4 v; v[0] = o[dt][4 * g]; v[1] = o[dt][4 * g + 1]; v[2] = o[dt][4 * g + 2]; v[3] = o[dt][4 * g + 3];
                *(f32x4*)(row + dt * 32 + 8 * g + 4 * hh) = v; }
        if (hh == 0) { row[128] = m_run; row[129] = lt; }
    } else {
        const int lt = c * 128 + (qt & 1) * 64 + lane;
        const int key0 = lt >> 4, ch = lt & 15;
        const size_t g0 = (size_t)key0 * HW + ch * 8;
        const int lk = key0 * A_KP + ch * 16, lv = A_KB + key0 * A_VP + ch * 16;
        f32x4 fa[16], fb[16];
#define S_TILE(i, P) ((i) < nc ? (P == 0 ? ck : cv) + (size_t)(t0 + (i)) * 64 * HW : (P == 0 ? kn : vn))
#define S_LOAD(F, i) do { const float* kp_ = S_TILE(i, 0) + g0; const float* vp_ = S_TILE(i, 1) + g0; \
        _Pragma("unroll") for (int j = 0; j < 4; ++j) { F[2 * j] = *(const f32x4*)(kp_ + (size_t)j * 16 * HW); F[2 * j + 1] = *(const f32x4*)(kp_ + (size_t)j * 16 * HW + 4); \
                                                        F[8 + 2 * j] = *(const f32x4*)(vp_ + (size_t)j * 16 * HW); F[8 + 2 * j + 1] = *(const f32x4*)(vp_ + (size_t)j * 16 * HW + 4); } } while (0)
#define S_PK(a, b) ((u32x4){pk2((a)[0], (a)[1]), pk2((a)[2], (a)[3]), pk2((b)[0], (b)[1]), pk2((b)[2], (b)[3])})
#define S_STORE(F, b) do { LAS unsigned char* sb_ = lds + (b) * A_STG; \
        _Pragma("unroll") for (int j = 0; j < 4; ++j) { *(LAS u32x4*)(sb_ + lk + j * 16 * A_KP) = S_PK(F[2 * j], F[2 * j + 1]); *(LAS u32x4*)(sb_ + lv + j * 16 * A_VP) = S_PK(F[8 + 2 * j], F[8 + 2 * j + 1]); } } while (0)
        S_LOAD(fa, 0);
        if (ntiles > 1) S_LOAD(fb, 1);
        S_STORE(fa, 0);
        LBAR();
        for (int t = 0; t < ntiles; t += 2) {
            if (t + 2 < ntiles) S_LOAD(fa, t + 2);
            if (t + 1 < ntiles) S_STORE(fb, 1);
            LBAR();
            if (t + 1 >= ntiles) break;
            if (t + 3 < ntiles) S_LOAD(fb, t + 3);
            if (t + 2 < ntiles) S_STORE(fa, 0);
            LBAR();
        }
#undef S_TILE
#undef S_LOAD
#undef S_PK
#undef S_STORE
    }
}

__device__ __forceinline__ void gla1_item(LAS unsigned char* lds, int ci, int h, const bf16* VI, const float* LOGF, float* UT, float* DD, bf16* STB,
                                          const float* state_in, float* state_out, int tid, int wave, int lane) {
    const int m0 = ci * 64;
#pragma unroll
    for (int i = 0; i < 2; ++i) { const int id = tid + 512 * i, key = id >> 4, ch = id & 15;
        *(LAS u32x4*)(lds + key * A_VP + ch * 16) = *(const u32x4*)(VI + (size_t)(m0 + key) * HW + h * 128 + ch * 8); }
    const int ct = wave & 3, dh = wave >> 2, r = lane & 31, hh = lane >> 5, k = ct * 32 + r;
    float lf[64];
    { const float* p = LOGF + (size_t)m0 * HW + h * 128 + k;
#pragma unroll
      for (int t = 0; t < 64; ++t) lf[t] = p[(size_t)t * HW]; }
    float suf = 0.f;
#pragma unroll
    for (int tt = 0; tt < 64; ++tt) { const float l = lf[63 - tt]; lf[63 - tt] = (1.f - fexp(l)) * fexp(suf); suf += l; }
    const float d = fexp(suf);
    bf16x8 kf[4];
#pragma unroll
    for (int ks = 0; ks < 4; ++ks) { u32x4 p;
        const unsigned a0 = pk2(lf[16 * ks + 0], lf[16 * ks + 1]), a1 = pk2(lf[16 * ks + 2], lf[16 * ks + 3]), a2 = pk2(lf[16 * ks + 4], lf[16 * ks + 5]), a3 = pk2(lf[16 * ks + 6], lf[16 * ks + 7]);
        const unsigned b0 = pk2(lf[16 * ks + 8], lf[16 * ks + 9]), b1 = pk2(lf[16 * ks + 10], lf[16 * ks + 11]), b2 = pk2(lf[16 * ks + 12], lf[16 * ks + 13]), b3 = pk2(lf[16 * ks + 14], lf[16 * ks + 15]);
        p.x = hh ? b0 : a0; p.y = hh ? b1 : a1; p.z = hh ? b2 : a2; p.w = hh ? b3 : a3;
        kf[ks] = __builtin_bit_cast(bf16x8, p); }
    __syncthreads();
    const int g16 = (lane >> 4) & 1, i16 = lane & 15, tq = i16 >> 2, tp = i16 & 3;
    const int vaddr = (8 * hh + tq) * A_VP + (g16 * 16 + 4 * tp) * 2;
    f32x16 acc[2];
#pragma unroll
    for (int e = 0; e < 2; ++e)
#pragma unroll
        for (int i = 0; i < 16; ++i) acc[e][i] = 0.f;
#pragma unroll
    for (int ks = 0; ks < 4; ++ks)
#pragma unroll
        for (int e = 0; e < 2; ++e) { const LAS unsigned char* va = lds + vaddr + (16 * ks) * A_VP + (2 * dh + e) * 64;
            const bf16x8 vf = tr2(va, va + 4 * A_VP);
            acc[e] = MFMA32(vf, kf[ks], acc[e]); }
    if (ci < NCH_P) {
        float* ut = UT + (size_t)(ci * NH + h) * 16384;
#pragma unroll
        for (int e = 0; e < 2; ++e)
#pragma unroll
            for (int i = 0; i < 16; ++i) ut[((2 * dh + e) * 32 + crow(i, hh)) * 128 + k] = acc[e][i];
        if (dh == 0 && hh == 0) DD[(ci * NH + h) * 128 + k] = d;
    } else {
        const int b = ci - NCH_P; const size_t sb = ((size_t)(b * NH + h) * 128 + k) * 128;
        bf16* stb = STB + (size_t)(ci * NH + h) * 16384;
#pragma unroll
        for (int e = 0; e < 2; ++e)
#pragma unroll
            for (int g = 0; g < 4; ++g) { const int dv0 = (2 * dh + e) * 32 + 8 * g + 4 * hh; const f32x4 s0 = *(const f32x4*)(state_in + sb + dv0); f32x4 o;
#pragma unroll
                for (int j = 0; j < 4; ++j) { o[j] = d * s0[j] + acc[e][4 * g + j]; stb[(dv0 + j) * 128 + k] = (bf16)(pk2(s0[j], 0.f) & 0xffffu); }
                *(f32x4*)(state_out + sb + dv0) = o; }
    }
    __syncthreads();
}

constexpr int G_QT = 0, G_KT = 64 * A_KP, G_VT = 2 * 64 * A_KP, G_PS = G_VT + 64 * A_VP, G_RS = G_PS + 2048;
__device__ __forceinline__ void gla3_item(LAS unsigned char* lds, int ci, int h, const bf16* QG, const bf16* VI, const bf16* GG, const float* LOGF, const bf16* STB,
                                          const float* hgn, bf16* MIX, int tid, int wave, int lane) {
    const int m0 = ci * 64;
#pragma unroll
    for (int i = 0; i < 2; ++i) { const int id = tid + 512 * i, key = id >> 4, ch = id & 15;
        *(LAS u32x4*)(lds + G_VT + key * A_VP + ch * 16) = *(const u32x4*)(VI + (size_t)(m0 + key) * HW + h * 128 + ch * 8); }
    {
        const int k = tid & 127, q4 = tid >> 7;
        const size_t base = (size_t)(m0 + q4 * 16) * HW + h * 128 + k;
        float lf[16], qg[16]; float ps = 0.f;
#pragma unroll
        for (int i = 0; i < 16; ++i) { lf[i] = LOGF[base + (size_t)i * HW]; qg[i] = bf2f(QG[base + (size_t)i * HW]); ps += lf[i]; }
        LAS float* PS = (LAS float*)(lds + G_PS);
        PS[q4 * 128 + k] = ps;
        __syncthreads();
        float b = 0.f;
#pragma unroll
        for (int j = 0; j < 3; ++j) if (j < q4) b += PS[j * 128 + k];
#pragma unroll
        for (int i = 0; i < 16; ++i) { b += lf[i]; const float qv = qg[i] * fexp(b), kv = (1.f - fexp(lf[i])) * fexp(-b);
            const int t = q4 * 16 + i;
            *(LAS bf16*)(lds + G_QT + t * A_KP + k * 2) = (bf16)(pk2(qv, 0.f) & 0xffffu);
            *(LAS bf16*)(lds + G_KT + t * A_KP + k * 2) = (bf16)(pk2(kv, 0.f) & 0xffffu); }
    }
    __syncthreads();
    const int vt = wave & 3, tt = wave >> 2, r = lane & 31, hh = lane >> 5;
    bf16x8 qf[8];
#pragma unroll
    for (int ks = 0; ks < 8; ++ks) qf[ks] = *(const LAS bf16x8*)(lds + G_QT + (tt * 32 + r) * A_KP + (16 * ks + 8 * hh) * 2);
    f32x16 acc;
#pragma unroll
    for (int i = 0; i < 16; ++i) acc[i] = 0.f;
    { const bf16* sp = STB + (size_t)(ci * NH + h) * 16384 + (size_t)(vt * 32 + r) * 128 + 8 * hh;
#pragma unroll
      for (int ks = 0; ks < 8; ++ks) { const bf16x8 sf = *(const bf16x8*)(sp + 16 * ks); acc = MFMA32(sf, qf[ks], acc); } }
    const int g16 = (lane >> 4) & 1, i16 = lane & 15, tq = i16 >> 2, tp = i16 & 3;
    const int vaddr = G_VT + (4 * hh + tq) * A_VP + (vt * 32 + g16 * 16 + 4 * tp) * 2;
#pragma unroll
    for (int st = 0; st < 2; ++st) {
        if (st <= tt) {
            f32x16 a;
#pragma unroll
            for (int i = 0; i < 16; ++i) a[i] = 0.f;
#pragma unroll
            for (int ks = 0; ks < 8; ++ks) { const bf16x8 kf = *(const LAS bf16x8*)(lds + G_KT + (st * 32 + r) * A_KP + (16 * ks + 8 * hh) * 2); a = MFMA32(kf, qf[ks], a); }
            if (st == tt) {
#pragma unroll
                for (int i = 0; i < 16; ++i) if (crow(i, hh) > r) a[i] = 0.f;
            }
            const bf16x8 p0 = pack8(a, 0), p1 = pack8(a, 1);
            const LAS unsigned char* va = lds + vaddr + (st * 32) * A_VP;
            acc = MFMA32(tr2(va, va + 8 * A_VP), p0, acc);
            acc = MFMA32(tr2(va + 16 * A_VP, va + 24 * A_VP), p1, acc);
        }
    }
    float ssq = 0.f;
#pragma unroll
    for (int i = 0; i < 16; ++i) ssq += acc[i] * acc[i];
    ssq += __shfl_xor(ssq, 32);
    LAS float* RS = (LAS float*)(lds + G_RS);
    if (hh == 0) RS[(tt * 4 + vt) * 32 + r] = ssq;
    __syncthreads();
    const float tot = (RS[(tt * 4 + 0) * 32 + r] + RS[(tt * 4 + 1) * 32 + r]) + (RS[(tt * 4 + 2) * 32 + r] + RS[(tt * 4 + 3) * 32 + r]);
    const float rstd = __builtin_amdgcn_rsqf(tot * (1.f / 128.f) + EPS);
    const size_t row = (size_t)(m0 + tt * 32 + r);
#pragma unroll
    for (int g = 0; g < 4; ++g) { const int dv0 = vt * 32 + 8 * g + 4 * hh; const f32x4 w = *(const f32x4*)(hgn + dv0);
        const u32x2 gg = *(const u32x2*)(GG + row * HW + h * 128 + dv0);
        const float g0 = __uint_as_float(gg.x << 16), g1 = __uint_as_float(gg.x & 0xffff0000u), g2 = __uint_as_float(gg.y << 16), g3 = __uint_as_float(gg.y & 0xffff0000u);
        u32x2 pw; pw.x = pk2(acc[4 * g] * rstd * w[0] * g0, acc[4 * g + 1] * rstd * w[1] * g1); pw.y = pk2(acc[4 * g + 2] * rstd * w[2] * g2, acc[4 * g + 3] * rstd * w[3] * g3);
        *(u32x2*)(MIX + row * DM + h * 128 + dv0) = pw; }
    __syncthreads();
}

#define XB_TMO      128
#define XB_XCNT(j)  (256  + 64 * (j))
#define XB_XSUB(j)  (1280 + 64 * (j))
#define XB_XGEN(j)  (2304 + 64 * (j))
#define XB_TOP      3328
#define XB_TOPGEN   3392
#define XCD_BAR_WORDS 3456
#define XB_SPIN_CAP (1u << 18)

__device__ __forceinline__ unsigned xb_ld(unsigned* p)              { return __hip_atomic_load(p, __ATOMIC_RELAXED, __HIP_MEMORY_SCOPE_AGENT); }
__device__ __forceinline__ unsigned xb_add(unsigned* p, unsigned v) { return __hip_atomic_fetch_add(p, v, __ATOMIC_RELAXED, __HIP_MEMORY_SCOPE_AGENT); }
__device__ __forceinline__ unsigned xb_xcc_id() { return (unsigned)__builtin_amdgcn_s_getreg((3 << 11) | 20) & 0xFu; }
#define XB_SPIN(cond, bar) do { unsigned _sp = 0; while (cond) { __builtin_amdgcn_s_sleep(1); \
    if ((++_sp & 255u) == 0u) { if (xb_ld(&(bar)[XB_TMO])) break; if (_sp > XB_SPIN_CAP) { atomicAdd(&(bar)[XB_TMO], 1u); break; } } } } while (0)

struct XcdBarrier {
    unsigned* bar; unsigned x;
    volatile LAS unsigned* st;
};

__device__ __forceinline__ XcdBarrier xcd_barrier_post(unsigned* bar, volatile LAS unsigned* st) {
    XcdBarrier b; b.bar = bar; b.x = xb_xcc_id(); b.st = st;
    if (threadIdx.x == 0) (void)xb_add(&bar[XB_XCNT(b.x)], 1u);
    return b;
}
__device__ __forceinline__ void xcd_barrier_complete(unsigned* bar, unsigned x, unsigned& nloc, unsigned& nx) {
    const unsigned G = gridDim.x * gridDim.y * gridDim.z;
    unsigned sum, cnt, mine, sp = 0u;
    for (;;) {
        sum = 0u; cnt = 0u; mine = 0u;
#pragma unroll
        for (unsigned j = 0; j < 16; ++j) { const unsigned c = xb_ld(&bar[XB_XCNT(j)]); sum += c; cnt += (c > 0u) ? 1u : 0u; mine = (j == x) ? c : mine; }
        if (sum == G) break;
        __builtin_amdgcn_s_sleep(1);
        if ((++sp & 255u) == 0u) { if (xb_ld(&bar[XB_TMO])) break; if (sp > XB_SPIN_CAP) { atomicAdd(&bar[XB_TMO], 1u); break; } }
    }
    nloc = mine > 0u ? mine : 1u; nx = cnt > 0u ? cnt : 1u;
}

__device__ __forceinline__ void xcd_barrier(const XcdBarrier& b) {
    asm volatile("s_waitcnt vmcnt(0)" ::: "memory");
    __syncthreads();
    if (threadIdx.x == 0) {
        unsigned* bar = b.bar;
        __builtin_amdgcn_s_waitcnt(0);
        unsigned nloc = b.st[0], nx = b.st[1];
        if (nloc == 0u) { xcd_barrier_complete(bar, b.x, nloc, nx); b.st[0] = nloc; b.st[1] = nx; }
        const unsigned old = xb_add(&bar[XB_XSUB(b.x)], 1u);
        const unsigned gen = old / nloc;
        if (old + 1u == (gen + 1u) * nloc) {
            __builtin_amdgcn_fence(__ATOMIC_RELEASE, "agent");
            asm volatile("s_waitcnt vmcnt(0)" ::: "memory");
            const unsigned og = xb_add(&bar[XB_TOP], 1u);
            const unsigned tg = og / nx;
            if (og + 1u == (tg + 1u) * nx) xb_add(&bar[XB_TOPGEN], 1u);
            else XB_SPIN(xb_ld(&bar[XB_TOPGEN]) == tg, bar);
            __builtin_amdgcn_fence(__ATOMIC_ACQUIRE, "agent");
            xb_add(&bar[XB_XGEN(b.x)], 1u);
            asm volatile("s_waitcnt vmcnt(0)" ::: "memory");
        } else {
            XB_SPIN(xb_ld(&bar[XB_XGEN(b.x)]) == gen, bar);
            __builtin_amdgcn_fence(__ATOMIC_ACQUIRE, "agent");
            asm volatile("s_waitcnt vmcnt(0)" ::: "memory");
        }
    }
    __syncthreads();
}

__global__ void __launch_bounds__(512, 2) hymba_fwd(Args a) {
    extern __shared__ __attribute__((aligned(16))) unsigned char lds_raw[];
    LAS unsigned char* lds = (LAS unsigned char*)lds_raw;
    cg::grid_group grid = cg::this_grid();
    if (threadIdx.x < 16) ((volatile LAS unsigned*)(lds + LDS_BYTES - 64))[threadIdx.x] = 0u;
    __syncthreads();
    const XcdBarrier xbar = xcd_barrier_post((unsigned*)(a.ws + WS_BAR), (volatile LAS unsigned*)(lds + LDS_BYTES - 64));
    const int tid = threadIdx.x, lane = tid & 63, wave = __builtin_amdgcn_readfirstlane(tid >> 6);
    const int G = gridDim.x, bid = blockIdx.x;
    unsigned char* ws = a.ws;
    const float *xp = a.in[0], *xs = a.in[1], *cache_k = a.in[2], *cache_v = a.in[3], *state_in = a.in[4], *norm_attn = a.in[5], *w_in = a.in[6], *lbw = a.in[7],
                *hgn = a.in[8], *lq1 = a.in[9], *lk1 = a.in[10], *lq2 = a.in[11], *lk2 = a.in[12], *subln = a.in[13], *w_out = a.in[14], *norm_mlp = a.in[15],
                *w_up = a.in[16], *w_down = a.in[17], *norm_final = a.in[18];
    float* out = a.out;
    float *SS2 = (float*)(ws + WS_SS2), *DD = (float*)(ws + WS_DD), *LOGF = (float*)(ws + WS_LOGF), *UT = (float*)(ws + WS_UT), *X2 = (float*)(ws + WS_X2);
    bf16 *WoutT = (bf16*)(ws + WS_WOUT), *WupT = (bf16*)(ws + WS_WUP), *WdownT = (bf16*)(ws + WS_WDOWN), *WinT = (bf16*)(ws + WS_WIN), *XN = (bf16*)(ws + WS_XN),
         *STB = (bf16*)(ws + WS_STB), *X2B = (bf16*)(ws + WS_X2B), *QG = (bf16*)(ws + WS_QG), *VI = (bf16*)(ws + WS_VI), *GG = (bf16*)(ws + WS_GG), *MIX = (bf16*)(ws + WS_MIX),
         *QB = (bf16*)(ws + WS_QB), *KB = (bf16*)(ws + WS_KB), *VB = (bf16*)(ws + WS_VB), *U = (bf16*)(ws + WS_U);
    float* AP = (float*)(ws + WS_AP);

    REP(0) {
        LAS float* scr = (LAS float*)(lds + wave * 16384);
        const int gw = bid * 8 + wave, NGW = G * 8;
        constexpr int I_IN = (DM / 64) * (INW / 32);
        for (int it = gw; it < I_IN; it += NGW) p0_transpose_item(w_in, DM, INW, WinT, nullptr, scr, it, lane);
        for (int m = gw; m < MT; m += NGW) {
            const f32x4* xr = (const f32x4*)(m < MP ? xp + (size_t)m * DM : xs + (size_t)(m - MP) * DM) + lane;
            f32x4 v[8]; float s = 0.f;
#pragma unroll
            for (int j = 0; j < 8; ++j) { v[j] = xr[64 * j]; s += (v[j][0] * v[j][0] + v[j][1] * v[j][1]) + (v[j][2] * v[j][2] + v[j][3] * v[j][3]); }
            const float rstd = __builtin_amdgcn_rsqf(wave_sum(s) * (1.f / DM) + EPS);
            u32x2* o8 = (u32x2*)(XN + (size_t)m * DM) + lane;
#pragma unroll
            for (int j = 0; j < 8; ++j) { const f32x4 g = ((const f32x4*)norm_attn)[lane + 64 * j]; u32x2 w;
                w.x = pk2(v[j][0] * rstd * g[0], v[j][1] * rstd * g[1]); w.y = pk2(v[j][2] * rstd * g[2], v[j][3] * rstd * g[3]); o8[64 * j] = w; }
        }
        for (int i = bid * 512 + tid; i < MT; i += G * 512) { SS2[i] = 0.f; }
    }
    grid.sync();

    REP(1) {
        pg8::Gemm g{XN, WinT, MT, INW, DM}; pg8::StaticOrder S; S.init(MT, INW, G, bid, DM / 64);
        Epi1 E{QG, VI, GG, QB, KB, VB, LOGF, out, lbw};
        pg8::gemm_phase<Epi1, pg8::StaticOrder, true, true>(lds, g, S, E);
        const int rem = S.nwg % G, nshort = rem ? G - rem : G, sidx = rem ? bid - rem : bid;
        if (sidx >= 0) {
            constexpr int I_OUT = (DM / 64) * (DM / 32), I_UP = (DM / 64) * (FF / 32), I_DN = (FF / 64) * (DM / 32);
            LAS float* scr = (LAS float*)(lds + wave * 16384);
            for (int it = sidx * 8 + wave; it < I_OUT + I_UP + I_DN; it += nshort * 8) {
                int r = it;
                if (r < I_OUT) { p0_transpose_item(w_out, DM, DM, WoutT, nullptr, scr, r, lane); continue; } r -= I_OUT;
                if (r < I_UP) { p0_transpose_item(w_up, DM, FF, WupT, norm_mlp, scr, r, lane); continue; } r -= I_UP;
                p0_transpose_item(w_down, FF, DM, WdownT, nullptr, scr, r, lane);
            }
        }
    }
    xcd_barrier(xbar);

    {
        REP(2) for (int it = bid; it < NCH * NH; it += G) gla1_item(lds, it >> 3, it & 7, VI, LOGF, UT, DD, STB, state_in, out + O_SS, tid, wave, lane);
        const float sa = wave_sum(lq1[lane] * lk1[lane]), sb = wave_sum(lq2[lane] * lk2[lane]);
        const float lam = __expf(sa) - __expf(sb) + LAM_INIT;
        { for (int rnd = 0; rnd * G < 256; ++rnd) {
            if (tid == 0) {
                unsigned* cnt = (unsigned*)(ws + WS_BAR) + 3520; int got = -1;
                for (int k = 0; k < 8 && got < 0; ++k) { const int hq = (int)((xbar.x + k) & 7u); const unsigned sl = atomicAdd(cnt + 64 * hq, 1u); if (sl < 32u) got = hq * 32 + (int)sl; }
                *(volatile LAS int*)(lds + LDS_BYTES - 32) = got;
            }
            __syncthreads();
            const int pp = __builtin_amdgcn_readfirstlane(*(volatile LAS int*)(lds + LDS_BYTES - 32));
            __syncthreads();
            if (pp < 0) continue;
            const int h = pp >> 5, i = pp & 31, spos = i % 3;
#pragma unroll 1
            for (int e = 0; e < 3; ++e) {
                int tid2 = tid; asm volatile("" : "+v"(tid2));
                const int lane2 = tid2 & 63;
                if (e == spos) {
                    const int su = pp >> 2, sq = pp & 3, b = su >> 3, hs = su & 7;
                    REP(8) attn_unit_s(lds, QB + (size_t)(MP + b * 64) * HW + hs * 128, cache_k + ((size_t)b * PAST * NH + hs) * 128, cache_v + ((size_t)b * PAST * NH + hs) * 128,
                                16 * sq, 16, sq == 3, out + O_KS + (size_t)(b * 64) * HW + hs * 128, out + O_VS + (size_t)(b * 64) * HW + hs * 128,
                                AP + (size_t)pp * 2 * AP_MAP, tid2, wave, lane2);
                }
                if (e < 2) { const int qb = e ? 63 - i : i;
                    REP(3) attn_unit(lds, QB + (size_t)(qb * 128) * HW + h * 128, KB + h * 128, VB + h * 128, 2 * (qb + 1),
                              MIX + (size_t)(qb * 128) * DM + HW + h * 128, lam, subln, tid2, wave, lane2); }
            }
        } }
    }
    xcd_barrier(xbar);

    REP(4) for (int gid = bid * 512 + tid; gid < NH * 16384; gid += G * 512) {
        const int h = gid >> 14, e = gid & 16383, k = e & 127, dv = e >> 7;
        float run = 0.f;
        for (int c0 = 0; c0 < NCH_P; c0 += 8) {
            float u[8], dd[8];
#pragma unroll
            for (int j = 0; j < 8; ++j) { u[j] = UT[(size_t)((c0 + j) * NH + h) * 16384 + e]; dd[j] = DD[((c0 + j) * NH + h) * 128 + k]; }
#pragma unroll
            for (int j = 0; j < 8; ++j) { STB[(size_t)((c0 + j) * NH + h) * 16384 + e] = (bf16)(pk2(run, 0.f) & 0xffffu); run = dd[j] * run + u[j]; }
        }
        out[O_SP + (size_t)(h * 128 + k) * 128 + dv] = run;
    }
    xcd_barrier(xbar);

    REP(5) for (int it = bid; it < NCH * NH; it += G) gla3_item(lds, it >> 3, it & 7, QG, VI, GG, LOGF, STB, hgn, MIX, tid, wave, lane);
    {
        const float sa = wave_sum(lq1[lane] * lk1[lane]), sb = wave_sum(lq2[lane] * lk2[lane]);
        const float lam = __expf(sa) - __expf(sb) + LAM_INIT;
        for (int rw = bid * 8 + wave; rw < 64 * 64; rw += G * 8) {
            const int su = rw >> 6, row = rw & 63, b = su >> 3, hs = su & 7;
            float oc[2][2];
#pragma unroll
            for (int c = 0; c < 2; ++c) {
                const float* p0 = AP + ((size_t)(su * 4) * 2 + c) * AP_MAP + (size_t)row * AP_ROW;
                float m[4], l[4]; float M = -3.0e38f;
#pragma unroll
                for (int q = 0; q < 4; ++q) { m[q] = p0[(size_t)q * 2 * AP_MAP + 128]; l[q] = p0[(size_t)q * 2 * AP_MAP + 129]; M = fmaxf(M, m[q]); }
                float L = 0.f, a0 = 0.f, a1 = 0.f;
#pragma unroll
                for (int q = 0; q < 4; ++q) { const float w = __builtin_amdgcn_exp2f(m[q] - M); L += w * l[q];
                    const float2 v = *(const float2*)(p0 + (size_t)q * 2 * AP_MAP + 2 * lane); a0 += w * v.x; a1 += w * v.y; }
                const float inv = 1.f / L; oc[c][0] = a0 * inv; oc[c][1] = a1 * inv;
            }
            const float v0 = oc[0][0] - lam * oc[1][0], v1 = oc[0][1] - lam * oc[1][1];
            const float ssq = wave_sum(v0 * v0 + v1 * v1);
            const float rms = __builtin_amdgcn_rsqf(ssq * (1.f / 128.f) + EPS) * (1.f - LAM_INIT);
            *(unsigned*)(MIX + (size_t)(MP + b * 64 + row) * DM + HW + hs * 128 + 2 * lane) = pk2(v0 * rms * subln[2 * lane], v1 * rms * subln[2 * lane + 1]);
        }
    }
    xcd_barrier(xbar);

    float* PART = (float*)(ws + WS_PART);
    {
        pg8::Gemm g{MIX, WoutT, MT, DM, DM}; SplitOrder S; S.init(MP, DM, G, bid, DM / 64, 16);
        Epi2 E{xp, xs, X2, X2B, SS2, PART};
        pg8::gemm_phase<Epi2, SplitOrder, true, true>(lds, g, S, E);
    }
    xcd_barrier(xbar);
    for (int r = wave * G + bid; r < MS; r += 8 * G) {
        const size_t m = (size_t)MP + r; float ss = 0.f;
#pragma unroll
        for (int j = 0; j < 8; ++j) { const int cix = (lane + 64 * j) * 4; f32x4 v = *(const f32x4*)(xs + (size_t)r * DM + cix);
#pragma unroll
            for (int p = 0; p < 16; ++p) v = v + *(const f32x4*)(PART + ((size_t)p * MS + r) * DM + cix);
            ss += (v[0] * v[0] + v[1] * v[1]) + (v[2] * v[2] + v[3] * v[3]);
            *(f32x4*)(X2 + m * DM + cix) = v; u32x2 w; w.x = pk2(v[0], v[1]); w.y = pk2(v[2], v[3]); *(u32x2*)(X2B + m * DM + cix) = w; }
        ss = wave_sum(ss);
        if (lane == 0) SS2[m] = ss;
    }
    xcd_barrier(xbar);

    REP(6) {
        pg8::Gemm g{X2B, WupT, MT, FF, DM}; SplitOrder S; S.init(MP, FF, G, bid, DM / 64, 4);
        Epi3 E{U, SS2, PART};
        pg8::gemm_phase<Epi3, SplitOrder, true, true>(lds, g, S, E);
    }
    xcd_barrier(xbar);
    for (int r = wave * G + bid; r < MS; r += 8 * G) {
        const size_t m = (size_t)MP + r;
        const float rstd = __builtin_amdgcn_rsqf(SS2[m] * (1.f / DM) + EPS);
#pragma unroll 4
        for (int j = 0; j < 32; ++j) { const int cix = (lane + 64 * j) * 4; f32x4 v = *(const f32x4*)(PART + (size_t)r * FF + cix);
#pragma unroll
            for (int p = 1; p < 4; ++p) v = v + *(const f32x4*)(PART + ((size_t)p * MS + r) * FF + cix);
#pragma unroll
            for (int q = 0; q < 4; ++q) { const float t = fmaxf(v[q] * rstd, 0.f); v[q] = t * t; }
            u32x2 w; w.x = pk2(v[0], v[1]); w.y = pk2(v[2], v[3]); *(u32x2*)(U + m * FF + cix) = w; }
    }
    xcd_barrier(xbar);

    REP(9) {
        pg8::Gemm g{U, WdownT, MT, DM, FF}; SplitOrder S; S.init(MP, DM, G, bid, FF / 64, 16);
        Epi4 E{X2, out + O_Y, PART};
        pg8::gemm_phase<Epi4, SplitOrder, true, true>(lds, g, S, E);
    }
    xcd_barrier(xbar);

    {
        const int gw = bid * 8 + wave, NGW = G * 8;
        for (int m = gw; m < MT; m += NGW) {
            f32x4* yr = (f32x4*)(out + O_Y + (size_t)m * DM) + lane;
            f32x4 v[8]; float ss = 0.f;
            if (m < MP) {
#pragma unroll
                for (int j = 0; j < 8; ++j) v[j] = yr[64 * j];
            } else {
                const int r = m - MP;
#pragma unroll
                for (int j = 0; j < 8; ++j) { const int cix = (lane + 64 * j) * 4; v[j] = *(const f32x4*)(X2 + (size_t)m * DM + cix);
#pragma unroll
                    for (int p = 0; p < 16; ++p) v[j] = v[j] + *(const f32x4*)(PART + ((size_t)p * MS + r) * DM + cix); }
            }
#pragma unroll
            for (int j = 0; j < 8; ++j) ss += (v[j][0] * v[j][0] + v[j][1] * v[j][1]) + (v[j][2] * v[j][2] + v[j][3] * v[j][3]);
            const float rstd = __builtin_amdgcn_rsqf(wave_sum(ss) * (1.f / DM) + EPS);
#pragma unroll
            for (int j = 0; j < 8; ++j) { const f32x4 g = ((const f32x4*)norm_final)[lane + 64 * j]; yr[64 * j] = v[j] * rstd * g; }
        }
    }
}

extern "C" void kernel_launch(void* const* d_in, const int* in_sizes, int n_in, void* d_out, int out_size, void* d_ws, size_t ws_size, hipStream_t stream) {
    static int grid = 0;
    if (grid == 0) {
        if (n_in != 19 || ws_size < WS_END) { fprintf(stderr, "kernel_launch: expected 19 inputs and >= %zu bytes of workspace; got %d, %zu\n", (size_t)WS_END, n_in, ws_size); grid = -1; return; }
        int dev = 0, cus = 0, per_cu = 0;
        hipGetDevice(&dev);
        hipDeviceGetAttribute(&cus, hipDeviceAttributeMultiprocessorCount, dev);
        if (hipFuncSetAttribute((const void*)hymba_fwd, hipFuncAttributeMaxDynamicSharedMemorySize, LDS_BYTES) != hipSuccess) { fprintf(stderr, "kernel_launch: hipFuncSetAttribute failed\n"); grid = -1; return; }
        if (hipOccupancyMaxActiveBlocksPerMultiprocessor(&per_cu, (const void*)hymba_fwd, 512, LDS_BYTES) != hipSuccess || per_cu < 1) { fprintf(stderr, "kernel_launch: occupancy query failed (%d)\n", per_cu); grid = -1; return; }
        grid = cus * (per_cu > 1 ? 1 : per_cu);
    }
    if (grid < 0) return;
    if (hipMemsetAsync((char*)d_ws + WS_BAR, 0, WS_BAR_BYTES, stream) != hipSuccess) { fprintf(stderr, "kernel_launch: memset failed\n"); return; }
    Args a{};
    for (int i = 0; i < 19; ++i) a.in[i] = (const float*)d_in[i];
    a.out = (float*)d_out; a.ws = (unsigned char*)d_ws;
    void* args[] = {&a};
    hipError_t e = hipLaunchCooperativeKernel((const void*)hymba_fwd, dim3(grid), dim3(512), args, LDS_BYTES, stream);
    if (e != hipSuccess) fprintf(stderr, "cooperative launch failed: %s (grid %d)\n", hipGetErrorString(e), grid);
}
```
